# Optimizing an MI355X kernel written in HIP

```python
import math
import jax, jax.numpy as jnp
from jax import lax
import numpy as np

D_MODEL = 1024
BATCH = 8
SEQ = 4096
DEPTH = 2
DEC_BATCH = 32
DEC_SEQ = 2048
PAST_LEN = 128

W_A = 512
CONV_W = 3
N_HEADS_B = 8
QK_NOPE = 64
QK_ROPE = 32
V_HEAD = 64
Q_LORA = 256
KV_LORA = 128
W_B = N_HEADS_B * V_HEAD
ROPE_THETA = 10000.0
CHUNK = 128
N_GROUPS_C = 4
W_C = 512
GC = W_C // N_GROUPS_C
N_HEADS_D = 8
HD_D = 64
W_D = N_HEADS_D * HD_D
DIL_PAIRS = ((128, 1), (512, 4), (2048, 16))
N_BUCKETS = 32
MAX_DIST = 1024
Q_BLOCK = 128
N_EVEN = (DEPTH + 1) // 2
N_ODD = DEPTH // 2
EPS = 1e-6
NEG = -1e30
F32 = jnp.float32

EVEN_SPLITS = (W_A, W_A, W_A, W_A, Q_LORA, KV_LORA, QK_ROPE, W_B)
ODD_SPLITS = (W_C, W_C, W_C, W_D, W_D, W_D, W_D)
EVEN_IN = sum(EVEN_SPLITS)
ODD_IN = sum(ODD_SPLITS)

kernel_name = 'hybrid_bidir_encoder_conv_mla_gmlp_dilated'


def _split(x, sizes):
    idx = np.cumsum(sizes)[:-1].tolist()
    return jnp.split(x, idx, axis=-1)


def rmsnorm(x, g):
    xf = x.astype(F32)
    y = xf * lax.rsqrt(jnp.mean(xf * xf, axis=-1, keepdims=True) + EPS)
    return (y * g.astype(F32)).astype(x.dtype)


def layernorm(x, g, b):
    xf = x.astype(F32)
    xc = xf - jnp.mean(xf, axis=-1, keepdims=True)
    y = xc * lax.rsqrt(jnp.mean(xc * xc, axis=-1, keepdims=True) + EPS)
    return (y * g.astype(F32) + b.astype(F32)).astype(x.dtype)


def rope(x):
    S, R = x.shape[1], x.shape[-1]
    half = R // 2
    inv = ROPE_THETA ** (-jnp.arange(half, dtype=F32) * 2.0 / R)
    ang = jnp.arange(S, dtype=F32)[:, None] * inv[None, :]
    cos = jnp.cos(ang)[None, :, None, :]
    sin = jnp.sin(ang)[None, :, None, :]
    xf = x.astype(F32)
    x1, x2 = xf[..., :half], xf[..., half:]
    return jnp.concatenate([x1 * cos - x2 * sin, x1 * sin + x2 * cos], axis=-1).astype(x.dtype)


def t5_bucket(rel):
    half = N_BUCKETS // 2
    max_exact = half // 2
    n = np.abs(rel)
    large = max_exact + (np.log(np.maximum(n, 1) / max_exact) / np.log(MAX_DIST / max_exact)
                         * (half - max_exact)).astype(np.int32)
    large = np.minimum(large, half - 1)
    return ((rel > 0).astype(np.int32) * half + np.where(n < max_exact, n, large)).astype(np.int32)


def dilated_offsets():
    return np.stack([d * np.arange(-(w // (2 * d)), w // (2 * d) + 1) for w, d in DIL_PAIRS]).astype(np.int32)


def short_conv(h, w):
    C = h.shape[-1]
    return lax.conv_general_dilated(h, w[:, None, :].astype(h.dtype), window_strides=(1,),
                                    padding=((CONV_W // 2, CONV_W // 2),),
                                    dimension_numbers=('NWC', 'WIO', 'NWC'),
                                    feature_group_count=C)


def dense_attention(q, k, v):
    B, S, H, dk = q.shape
    nb = S // Q_BLOCK
    scale = dk ** -0.5
    qb = q.reshape(B, nb, Q_BLOCK, H, dk).transpose(1, 0, 2, 3, 4)

    def block(qi):
        s = jnp.einsum('bqhd,bkhd->bhqk', qi, k).astype(F32) * scale
        p = jax.nn.softmax(s, axis=-1).astype(v.dtype)
        return jnp.einsum('bhqk,bkhd->bqhd', p, v)

    o = lax.map(block, qb)
    return o.transpose(1, 0, 2, 3, 4).reshape(B, S, H * v.shape[-1])


def dilated_attention(q, k, v, rel_bias):
    B, S, H, dh = q.shape
    offs = dilated_offsets()
    pad = int(np.abs(offs).max())
    bias = jnp.transpose(rel_bias[t5_bucket(offs)].astype(F32), (0, 2, 1))
    kp = jnp.pad(k, ((0, 0), (pad, pad), (0, 0), (0, 0)))
    vp = jnp.pad(v, ((0, 0), (pad, pad), (0, 0), (0, 0)))
    nb = S // Q_BLOCK
    qb = q.reshape(B, nb, Q_BLOCK, H, dh)
    scale = dh ** -0.5
    offs_j = jnp.asarray(offs)

    def one_seq(args):
        qs, ks, vs = args

        def one_block(inp):
            i, qi = inp
            pos = i * Q_BLOCK + jnp.arange(Q_BLOCK, dtype=jnp.int32)
            kidx = pos[:, None, None] + offs_j[None]
            valid = (kidx >= 0) & (kidx < S)
            kg = ks[kidx + pad]
            vg = vs[kidx + pad]
            s = jnp.einsum('qhd,qgkhd->qghk', qi, kg).astype(F32) * scale + bias[None]
            s = jnp.where(valid[:, :, None, :], s, NEG)
            lse = jax.nn.logsumexp(s, axis=-1)
            p = jnp.exp(s - lse[..., None]).astype(vs.dtype)
            og = jnp.einsum('qghk,qgkhd->qghd', p, vg)
            alpha = jax.nn.softmax(lse, axis=1).astype(vs.dtype)
            return jnp.einsum('qgh,qghd->qhd', alpha, og)

        return lax.map(one_block, (jnp.arange(nb, dtype=jnp.int32), qs))

    o = lax.map(one_seq, (qb, kp, vp))
    return o.reshape(B, S, H * dh)


def even_mixer(h, w_in, a_conv, q_norm, w_uq, kv_norm, w_ukv, q_gain, k_gain, w_out):
    B, S, _ = h.shape
    a_b, a_c, a_x, a_z, cq, ckv, kr, b_z = _split(h @ w_in, EVEN_SPLITS)
    ya = a_b * short_conv(a_c * a_x, a_conv) * jax.nn.silu(a_z)
    q = (rmsnorm(cq, q_norm) @ w_uq).reshape(B, S, N_HEADS_B, QK_NOPE + QK_ROPE)
    kv = (rmsnorm(ckv, kv_norm) @ w_ukv).reshape(B, S, N_HEADS_B, QK_NOPE + V_HEAD)
    k_nope, v = kv[..., :QK_NOPE], kv[..., QK_NOPE:]
    k_rope = jnp.broadcast_to(kr[:, :, None, :], (B, S, N_HEADS_B, QK_ROPE))
    k = jnp.concatenate([k_nope, k_rope], axis=-1)
    q = rmsnorm(q, q_gain)
    k = rmsnorm(k, k_gain)
    q = jnp.concatenate([q[..., :QK_NOPE], rope(q[..., QK_NOPE:])], axis=-1)
    k = jnp.concatenate([k[..., :QK_NOPE], rope(k[..., QK_NOPE:])], axis=-1)
    yb = dense_attention(q, k, v) * jax.nn.silu(b_z)
    return jnp.concatenate([ya, yb], axis=-1) @ w_out


def odd_mixer(h, w_in, c_vnorm_g, c_vnorm_b, c_ws, c_bs, dq_gain, dk_gain, rel_bias, w_out):
    B, S, _ = h.shape
    cu, cv, cz, dq, dk, dv, dz = _split(h @ w_in, ODD_SPLITS)
    u = jax.nn.gelu(cu)
    vv = layernorm(jax.nn.gelu(cv), c_vnorm_g, c_vnorm_b)
    vv = vv.reshape(B, S // CHUNK, CHUNK, N_GROUPS_C, GC)
    s = jnp.einsum('gpq,bnqgc->bnpgc', c_ws, vv) + c_bs.T[None, None, :, :, None]
    yc = u * s.reshape(B, S, W_C) * jax.nn.silu(cz)
    q = rmsnorm(dq.reshape(B, S, N_HEADS_D, HD_D), dq_gain)
    k = rmsnorm(dk.reshape(B, S, N_HEADS_D, HD_D), dk_gain)
    v = dv.reshape(B, S, N_HEADS_D, HD_D)
    yd = dilated_attention(q, k, v, rel_bias) * jax.nn.silu(dz)
    return jnp.concatenate([yc, yd], axis=-1) @ w_out


def trunk(x, c, norm_g, w_mod, b_mod, rel_bias, w_in_e, a_conv, mla_q_norm, mla_w_uq, mla_kv_norm,
          mla_w_ukv, mla_q_gain, mla_k_gain, w_out_e, w_in_o, c_vnorm_g, c_vnorm_b, c_ws, c_bs,
          d_q_gain, d_k_gain, w_out_o):
    for layer in range(DEPTH):
        mod = jax.nn.silu(c) @ w_mod[layer] + b_mod[layer]
        shift, scale, gate = jnp.split(mod[:, None, :], 3, axis=-1)
        h = rmsnorm(x, norm_g[layer]) * (1 + scale) + shift
        i = layer // 2
        if layer % 2 == 0:
            y = even_mixer(h, w_in_e[i], a_conv[i], mla_q_norm[i], mla_w_uq[i], mla_kv_norm[i],
                           mla_w_ukv[i], mla_q_gain[i], mla_k_gain[i], w_out_e[i])
        else:
            y = odd_mixer(h, w_in_o[i], c_vnorm_g[i], c_vnorm_b[i], c_ws[i], c_bs[i],
                          d_q_gain[i], d_k_gain[i], rel_bias, w_out_o[i])
        x = x + gate * y
    return x


def setup_inputs(seed: int = 0) -> dict:
    key = jax.random.key(seed)
    ks = jax.random.split(key, 32)

    def nrm(k, shape, s):
        return jax.random.normal(k, shape, F32) * s

    def gain(k, shape):
        return 1.0 + 0.05 * jax.random.normal(k, shape, F32)

    D = D_MODEL
    return {
        'x_prompt': nrm(ks[0], (BATCH, SEQ, D), 1.0),
        'x_sample': nrm(ks[1], (DEC_BATCH, DEC_SEQ, D), 1.0),
        'c_prompt': nrm(ks[2], (BATCH, D), 1.0),
        'c_sample': nrm(ks[3], (DEC_BATCH, D), 1.0),
        'norm_g': gain(ks[4], (DEPTH, D)),
        'w_mod': nrm(ks[5], (DEPTH, D, 3 * D), 0.5 * D ** -0.5),
        'b_mod': nrm(ks[6], (DEPTH, 3 * D), 0.02),
        'rel_bias': nrm(ks[7], (N_BUCKETS, N_HEADS_D), 0.5),
        'w_in_e': nrm(ks[8], (N_EVEN, D, EVEN_IN), D ** -0.5),
        'a_conv': nrm(ks[9], (N_EVEN, CONV_W, W_A), CONV_W ** -0.5),
        'mla_q_norm': gain(ks[10], (N_EVEN, Q_LORA)),
        'mla_w_uq': nrm(ks[11], (N_EVEN, Q_LORA, N_HEADS_B * (QK_NOPE + QK_ROPE)), Q_LORA ** -0.5),
        'mla_kv_norm': gain(ks[12], (N_EVEN, KV_LORA)),
        'mla_w_ukv': nrm(ks[13], (N_EVEN, KV_LORA, N_HEADS_B * (QK_NOPE + V_HEAD)), KV_LORA ** -0.5),
        'mla_q_gain': gain(ks[14], (N_EVEN, QK_NOPE + QK_ROPE)),
        'mla_k_gain': gain(ks[15], (N_EVEN, QK_NOPE + QK_ROPE)),
        'w_out_e': nrm(ks[16], (N_EVEN, W_A + W_B, D), (W_A + W_B) ** -0.5),
        'w_in_o': nrm(ks[17], (N_ODD, D, ODD_IN), D ** -0.5),
        'c_vnorm_g': gain(ks[18], (N_ODD, W_C)),
        'c_vnorm_b': nrm(ks[19], (N_ODD, W_C), 0.02),
        'c_ws': nrm(ks[20], (N_ODD, N_GROUPS_C, CHUNK, CHUNK), CHUNK ** -0.5),
        'c_bs': gain(ks[21], (N_ODD, N_GROUPS_C, CHUNK)),
        'd_q_gain': gain(ks[22], (N_ODD, HD_D)),
        'd_k_gain': gain(ks[23], (N_ODD, HD_D)),
        'w_out_o': nrm(ks[24], (N_ODD, W_C + W_D, D), (W_C + W_D) ** -0.5),
    }


def reference(x_prompt, x_sample, c_prompt, c_sample, norm_g, w_mod, b_mod, rel_bias, w_in_e, a_conv,
              mla_q_norm, mla_w_uq, mla_kv_norm, mla_w_ukv, mla_q_gain, mla_k_gain, w_out_e, w_in_o,
              c_vnorm_g, c_vnorm_b, c_ws, c_bs, d_q_gain, d_k_gain, w_out_o):
    y_prompt = trunk(x_prompt, c_prompt, norm_g, w_mod, b_mod, rel_bias, w_in_e, a_conv, mla_q_norm,
                     mla_w_uq, mla_kv_norm, mla_w_ukv, mla_q_gain, mla_k_gain, w_out_e, w_in_o,
                     c_vnorm_g, c_vnorm_b, c_ws, c_bs, d_q_gain, d_k_gain, w_out_o)
    y_sample = trunk(x_sample, c_sample, norm_g, w_mod, b_mod, rel_bias, w_in_e, a_conv, mla_q_norm,
                     mla_w_uq, mla_kv_norm, mla_w_ukv, mla_q_gain, mla_k_gain, w_out_e, w_in_o,
                     c_vnorm_g, c_vnorm_b, c_ws, c_bs, d_q_gain, d_k_gain, w_out_o)
    return (y_prompt, y_sample)
```

```cpp
#include <hip/hip_runtime.h>
#include <cstdio>
#include <cstdint>

#define LAS __attribute__((address_space(3)))
typedef unsigned short bf16_t;
typedef short bf16x8 __attribute__((ext_vector_type(8)));
typedef short s16x4 __attribute__((ext_vector_type(4)));
typedef float f32x4 __attribute__((ext_vector_type(4)));
typedef float f32x16 __attribute__((ext_vector_type(16)));
typedef unsigned u32x4 __attribute__((ext_vector_type(4)));
typedef unsigned u32x2 __attribute__((ext_vector_type(2)));

constexpr int D = 1024, MP = 32768, MS = 65536, M = MP + MS, NB = 40;
constexpr int LDP0 = 3072, LDP1 = 3584;
constexpr float EPS = 1e-6f, LOG2E = 1.4426950408889634f;
constexpr float QSCALE_B = 0.10206207261596577f * LOG2E;
constexpr float QSCALE_D = 0.125f * LOG2E;
constexpr int LDS_BYTES = 147456;
#ifndef REP_PREP
#define REP_PREP 1
#endif
#ifndef REP_PRE0
#define REP_PRE0 1
#endif
#ifndef REP_GMLP
#define REP_GMLP 1
#endif
#ifndef REP_MERGE
#define REP_MERGE 1
#endif
#ifndef REP_BAR
#define REP_BAR 1
#endif
#ifndef REP_ATTN
#define REP_ATTN 1
#endif
#ifndef REP_DIL
#define REP_DIL 1
#endif
#ifndef REP_GEMM
#define REP_GEMM 1
#endif

constexpr size_t MiB = 1u << 20;
constexpr size_t WS_CTL = 0;
constexpr size_t WS_MOD = 1 * MiB;
constexpr size_t WS_WINE = 2 * MiB;
constexpr size_t WS_WINO = 8 * MiB;
constexpr size_t WS_WOE = 15 * MiB;
constexpr size_t WS_WOO = 17 * MiB;
constexpr size_t WS_WUQ = 19 * MiB;
constexpr size_t WS_WUKV = 19 * MiB + 512 * 1024;
constexpr size_t WS_CWS = 20 * MiB;
constexpr size_t WS_BIAS = 20 * MiB + 256 * 1024;
constexpr size_t WS_LSE = 21 * MiB;
constexpr size_t WS_SW = 30 * MiB;
constexpr size_t WS_ROWSS = 31 * MiB;
constexpr size_t WS_H = 32 * MiB;
constexpr size_t WS_P = 224 * MiB;
constexpr size_t WS_V = 896 * MiB;
constexpr size_t WS_END = 992 * MiB;
constexpr size_t OUT_Q = 0, OUT_KV = 144 * MiB;

struct Params {
    const float *xp, *xs, *cp, *cs, *norm_g, *w_mod, *b_mod, *rel_bias, *w_in_e, *a_conv, *q_norm, *w_uq, *kv_norm, *w_ukv,
        *q_gain, *k_gain, *w_out_e, *w_in_o, *vn_g, *vn_b, *c_ws, *c_bs, *dq_gain, *dk_gain, *w_out_o;
    float* out; unsigned char* ws; unsigned long long pad;
};

__device__ __forceinline__ unsigned pk2(float lo, float hi) { unsigned r; asm volatile("v_cvt_pk_bf16_f32 %0, %1, %2" : "=v"(r) : "v"(lo), "v"(hi)); return r; }
__device__ __forceinline__ float bflo(unsigned w) { return __uint_as_float(w << 16); }
__device__ __forceinline__ float bfhi(unsigned w) { return __uint_as_float(w & 0xffff0000u); }
__device__ __forceinline__ float wave_sum(float v) {
#pragma unroll
    for (int o = 1; o < 64; o <<= 1) v += __shfl_xor(v, o);
    return v;
}
__device__ __forceinline__ float sum8(float v) { v += __shfl_xor(v, 1); v += __shfl_xor(v, 2); v += __shfl_xor(v, 4); return v; }
__device__ __forceinline__ float fexp2(float x) { return __builtin_amdgcn_exp2f(x); }
__device__ __forceinline__ float frcp(float x) { return __builtin_amdgcn_rcpf(x); }
__device__ __forceinline__ float silu(float x) { return x * frcp(1.f + fexp2(-x * LOG2E)); }
__device__ __forceinline__ float gelu_t(float x) { const float u = 0.7978845608028654f * (x + 0.044715f * x * x * x); return x * frcp(1.f + fexp2(-2.f * LOG2E * u)); }
__device__ __forceinline__ int crow(int r, int hi) { return (r & 3) + 8 * (r >> 2) + 4 * hi; }
__device__ __forceinline__ int bid_of(int m) { return m < MP ? (m >> 12) : 8 + ((m - MP) >> 11); }
__device__ __forceinline__ float swap_max(float x) { auto rr = __builtin_amdgcn_permlane32_swap(__float_as_uint(x), __float_as_uint(x), false, false); return fmaxf(__uint_as_float(rr[0]), __uint_as_float(rr[1])); }
__device__ __forceinline__ float swap_sum(float x) { auto rr = __builtin_amdgcn_permlane32_swap(__float_as_uint(x), __float_as_uint(x), false, false); return __uint_as_float(rr[0]) + __uint_as_float(rr[1]); }
__device__ __forceinline__ int opaque_tid() { int t = threadIdx.x; asm volatile("" : "+v"(t)); return t; }
#define LDS_WAIT() asm volatile("s_waitcnt lgkmcnt(0)" ::: "memory")
#define VM_WAIT() asm volatile("s_waitcnt vmcnt(0)" ::: "memory")
#define SBAR() __builtin_amdgcn_sched_barrier(0)
template <int OFF> __device__ __forceinline__ s16x4 tr_read(unsigned addr) { s16x4 r; asm volatile("ds_read_b64_tr_b16 %0, %1 offset:%2" : "=&v"(r) : "v"(addr), "i"(OFF) : "memory"); return r; }
#define PK8(L, H) (bf16x8){L[0], L[1], L[2], L[3], H[0], H[1], H[2], H[3]}

__device__ __forceinline__ void gbar1(unsigned* bar, unsigned& gen) {
    asm volatile("s_waitcnt vmcnt(0) lgkmcnt(0)" ::: "memory");
    __syncthreads();
    if (threadIdx.x == 0) {
        __builtin_amdgcn_fence(__ATOMIC_RELEASE, "agent");
        asm volatile("s_waitcnt vmcnt(0)" ::: "memory");
        const unsigned target = (gen + 1u) * gridDim.x;
        __hip_atomic_fetch_add(bar, 1u, __ATOMIC_RELAXED, __HIP_MEMORY_SCOPE_AGENT);
        unsigned spins = 0;
        while (__hip_atomic_load(bar, __ATOMIC_RELAXED, __HIP_MEMORY_SCOPE_AGENT) < target) { __builtin_amdgcn_s_sleep(2); if (++spins > (1u << 22)) break; }
        __builtin_amdgcn_fence(__ATOMIC_ACQUIRE, "agent");
        asm volatile("s_waitcnt vmcnt(0)" ::: "memory");
    }
    ++gen;
    __syncthreads();
}

__device__ __forceinline__ void gbar(unsigned* bar, unsigned& gen) { for (int r = 0; r < REP_BAR; ++r) gbar1(bar, gen); }

#define XB_TMO      128
#define XB_XCNT(j)  (256  + 64 * (j))
#define XB_XSUB(j)  (1280 + 64 * (j))
#define XB_XGEN(j)  (2304 + 64 * (j))
#define XB_TOP      3328
#define XB_TOPGEN   3392
#define XCD_BAR_WORDS 3456
#define XB_SPIN_CAP (1u << 22)
__device__ __forceinline__ unsigned xb_ld(unsigned* p)              { return __hip_atomic_load(p, __ATOMIC_RELAXED, __HIP_MEMORY_SCOPE_AGENT); }
__device__ __forceinline__ unsigned xb_add(unsigned* p, unsigned v) { return __hip_atomic_fetch_add(p, v, __ATOMIC_RELAXED, __HIP_MEMORY_SCOPE_AGENT); }
__device__ __forceinline__ unsigned xb_xcc_id() { return (unsigned)__builtin_amdgcn_s_getreg((3 << 11) | 20) & 0xFu; }
#define XB_SPIN(cond, bar) do { unsigned _sp = 0; while (cond) { __builtin_amdgcn_s_sleep(1); \
    if ((++_sp & 255u) == 0u) { if (xb_ld(&(bar)[XB_TMO])) break; if (_sp > XB_SPIN_CAP) { atomicAdd(&(bar)[XB_TMO], 1u); break; } } } } while (0)
struct XcdBarrier { unsigned* bar; unsigned x; volatile LAS unsigned* st; };
__device__ __forceinline__ XcdBarrier xcd_barrier_post(unsigned* bar, volatile LAS unsigned* st) {
    XcdBarrier b; b.bar = bar; b.x = xb_xcc_id(); b.st = st;
    if (threadIdx.x == 0) (void)xb_add(&bar[XB_XCNT(b.x)], 1u);
    return b;
}
__device__ __forceinline__ void xcd_barrier_complete(unsigned* bar, unsigned x, unsigned& nloc, unsigned& nx) {
    const unsigned G = gridDim.x * gridDim.y * gridDim.z;
    unsigned sum, cnt, mine, sp = 0u;
    for (;;) {
        sum = 0u; cnt = 0u; mine = 0u;
#pragma unroll
        for (unsigned j = 0; j < 16; ++j) { const unsigned c = xb_ld(&bar[XB_XCNT(j)]); sum += c; cnt += (c > 0u) ? 1u : 0u; mine = (j == x) ? c : mine; }
        if (sum == G) break;
        __builtin_amdgcn_s_sleep(1);
        if ((++sp & 255u) == 0u) { if (xb_ld(&bar[XB_TMO])) break; if (sp > XB_SPIN_CAP) { atomicAdd(&bar[XB_TMO], 1u); break; } }
    }
    nloc = mine > 0u ? mine : 1u; nx = cnt > 0u ? cnt : 1u;
}
__device__ __forceinline__ void xcd_barrier(const XcdBarrier& b) {
    asm volatile("s_waitcnt vmcnt(0)" ::: "memory");
    __syncthreads();
    if (threadIdx.x == 0) {
        unsigned* bar = b.bar;
        __builtin_amdgcn_s_waitcnt(0);
        unsigned nloc = b.st[0], nx = b.st[1];
        if (nloc == 0u) { xcd_barrier_complete(bar, b.x, nloc, nx); b.st[0] = nloc; b.st[1] = nx; }
        const unsigned old = xb_add(&bar[XB_XSUB(b.x)], 1u);
        const unsigned gen = old / nloc;
        if (old + 1u == (gen + 1u) * nloc) {
            __builtin_amdgcn_fence(__ATOMIC_RELEASE, "agent");
            asm volatile("s_waitcnt vmcnt(0)" ::: "memory");
            const unsigned og = xb_add(&bar[XB_TOP], 1u);
            const unsigned tg = og / nx;
            if (og + 1u == (tg + 1u) * nx) xb_add(&bar[XB_TOPGEN], 1u);
            else XB_SPIN(xb_ld(&bar[XB_TOPGEN]) == tg, bar);
            __builtin_amdgcn_fence(__ATOMIC_ACQUIRE, "agent");
            xb_add(&bar[XB_XGEN(b.x)], 1u);
            asm volatile("s_waitcnt vmcnt(0)" ::: "memory");
        } else {
            XB_SPIN(xb_ld(&bar[XB_XGEN(b.x)]) == gen, bar);
            __builtin_amdgcn_fence(__ATOMIC_ACQUIRE, "agent");
            asm volatile("s_waitcnt vmcnt(0)" ::: "memory");
        }
    }
    __syncthreads();
}
namespace pg8 {
constexpr int BM = 256, BK = 64, HALF = 128, HTB = HALF * BK * 2, STAGE_BYTES = 8 * HTB, NXCD = 8, WGM = 8;
__device__ __forceinline__ int lds_byte(int r, int c) { const int st = (r >> 4) * 2 + (c >> 5), rr = r & 15, cc = c & 31, ob = rr * 64 + cc * 2; return st * 1024 + (ob ^ (((ob >> 9) & 1) << 5)); }
__device__ __forceinline__ void stage_rc(int b, int& R, int& C) { const int st = b / 1024, sb = b % 1024, swz = sb ^ (((sb >> 9) & 1) << 5); R = (st >> 1) * 16 + swz / 64; C = (st & 1) * 32 + (swz % 64) / 2; }
__device__ __forceinline__ int perm32(int rho) { const int n = rho >> 4, i = rho & 15; return 8 * (i >> 2) + 4 * n + (i & 3); }
struct Unit { int pm, pn; };
struct Gemm { const bf16_t* A; const bf16_t* Bt; int M, N, K, lda; int kjt, kjb; };
struct StaticOrder {
    int nM, nN, nwg, G, c;
    __device__ void init(int M_, int N_, int G_, int c_) { nM = M_ / BM; nN = N_ / BM; nwg = nM * nN; G = G_; c = c_; }
    __device__ bool next(int i, Unit& u) const {
        const long L = (long)i * G + c; if (L >= nwg) return false;
        int wgid = (int)L; { const int q = nwg / NXCD, r = nwg % NXCD, xcd = wgid % NXCD, off = wgid / NXCD; wgid = (xcd < r ? xcd * (q + 1) : r * (q + 1) + (xcd - r) * q) + off; }
        const int nig = WGM * nN, gid = wgid / nig, fm = gid * WGM, gsz = (nM - fm) < WGM ? (nM - fm) : WGM;
        u.pm = fm + ((wgid % nig) % gsz); u.pn = (wgid % nig) / gsz; return true;
    }
};
struct EpiBf16 {
    bf16_t* O; int ldc;
    __device__ __forceinline__ void operator()(const f32x4 (&acc)[2][2][4][2], const Unit& u, int wr, int wc, int fr, int fq) const {
        const int row0 = u.pm * BM + wr * 64 + fr, col0 = u.pn * BM + wc * 32 + 8 * fq;
#pragma unroll
        for (int ai = 0; ai < 2; ++ai)
#pragma unroll
            for (int m = 0; m < 4; ++m) { bf16_t* rowp = O + (size_t)(row0 + ai * HALF + m * 16) * ldc + col0;
#pragma unroll
                for (int bj = 0; bj < 2; ++bj) { const f32x4 v0 = acc[ai][bj][m][0], v1 = acc[ai][bj][m][1];
                    u32x4 w; w.x = pk2(v0[0], v0[1]); w.y = pk2(v0[2], v0[3]); w.z = pk2(v1[0], v1[1]); w.w = pk2(v1[2], v1[3]);
                    *(u32x4*)(rowp + bj * HALF) = w; } }
    }
};
struct EpiResid {
    const float* bp; const float* bs; float* out; const float* gate;
    __device__ __forceinline__ void operator()(const f32x4 (&acc)[2][2][4][2], const Unit& u, int wr, int wc, int fr, int fq) const {
        const int row0 = u.pm * BM + wr * 64 + fr, col0 = u.pn * BM + wc * 32 + 8 * fq;
        const int bid = bid_of(u.pm * BM);
        const float* gp = gate + (size_t)bid * 3072 + col0;
        f32x4 g[2][2];
#pragma unroll
        for (int bj = 0; bj < 2; ++bj) { g[bj][0] = *(const f32x4*)(gp + bj * HALF); g[bj][1] = *(const f32x4*)(gp + bj * HALF + 4); }
#pragma unroll
        for (int ai = 0; ai < 2; ++ai)
#pragma unroll
            for (int m = 0; m < 4; ++m) { const int row = row0 + ai * HALF + m * 16;
                const float* bptr = (row < MP ? bp + (size_t)row * D : bs + (size_t)(row - MP) * D) + col0; float* optr = out + (size_t)row * D + col0;
#pragma unroll
                for (int bj = 0; bj < 2; ++bj) {
                    const f32x4 b0 = *(const f32x4*)(bptr + bj * HALF), b1 = *(const f32x4*)(bptr + bj * HALF + 4);
                    *(f32x4*)(optr + bj * HALF) = b0 + g[bj][0] * acc[ai][bj][m][0]; *(f32x4*)(optr + bj * HALF + 4) = b1 + g[bj][1] * acc[ai][bj][m][1]; } }
    }
};

struct EpiResid0 {
    const float* bp; const float* bs; float* out; const float* mod0; const float* mod1; const float* ng1; bf16_t* Hx; float* rowss;
    __device__ __forceinline__ void operator()(const f32x4 (&acc)[2][2][4][2], const Unit& u, int wr, int wc, int fr, int fq) const {
        const int row0 = u.pm * BM + wr * 64 + fr, col0 = u.pn * BM + wc * 32 + 8 * fq;
        const int bid = bid_of(u.pm * BM);
        const float* gp = mod0 + (size_t)bid * 3072 + 2048 + col0;
        const float* sp = mod1 + (size_t)bid * 3072 + 1024 + col0;
        f32x4 g[2][2], gv[2][2];
#pragma unroll
        for (int bj = 0; bj < 2; ++bj)
#pragma unroll
            for (int n = 0; n < 2; ++n) { g[bj][n] = *(const f32x4*)(gp + bj * HALF + 4 * n);
                gv[bj][n] = *(const f32x4*)(ng1 + col0 + bj * HALF + 4 * n) * (*(const f32x4*)(sp + bj * HALF + 4 * n) + 1.f); }
#pragma unroll
        for (int ai = 0; ai < 2; ++ai)
#pragma unroll
            for (int m = 0; m < 4; ++m) { const int row = row0 + ai * HALF + m * 16;
                const float* bptr = (row < MP ? bp + (size_t)row * D : bs + (size_t)(row - MP) * D) + col0; float* optr = out + (size_t)row * D + col0;
                bf16_t* hptr = Hx + (size_t)row * D + col0;
                float ss = 0.f;
#pragma unroll
                for (int bj = 0; bj < 2; ++bj) {
                    const f32x4 o0 = *(const f32x4*)(bptr + bj * HALF) + g[bj][0] * acc[ai][bj][m][0], o1 = *(const f32x4*)(bptr + bj * HALF + 4) + g[bj][1] * acc[ai][bj][m][1];
                    *(f32x4*)(optr + bj * HALF) = o0; *(f32x4*)(optr + bj * HALF + 4) = o1;
                    ss += (o0[0] * o0[0] + o0[1] * o0[1]) + (o0[2] * o0[2] + o0[3] * o0[3]) + (o1[0] * o1[0] + o1[1] * o1[1]) + (o1[2] * o1[2] + o1[3] * o1[3]);
                    const f32x4 h0 = o0 * gv[bj][0], h1 = o1 * gv[bj][1];
                    u32x4 w; w.x = pk2(h0[0], h0[1]); w.y = pk2(h0[2], h0[3]); w.z = pk2(h1[0], h1[1]); w.w = pk2(h1[2], h1[3]);
                    *(u32x4*)(hptr + bj * HALF) = w; }
                ss += __shfl_xor(ss, 16); ss += __shfl_xor(ss, 32);
                if (fq == 0) atomicAdd(rowss + row, ss); }
    }
};
struct EpiInO {
    bf16_t* O; const float* qgain; const float* kgain; const float* rowss; const float* sW;
    __device__ __forceinline__ void operator()(const f32x4 (&acc)[2][2][4][2], const Unit& u, int wr, int wc, int fr, int fq) const {
        constexpr int ldc = LDP1;
        const int row0 = u.pm * BM + wr * 64 + fr;
        const float* swb = sW + (size_t)bid_of(u.pm * BM) * LDP1;
        if (u.pn >= 6 && u.pn < 10) {
            const bool isq = u.pn < 8; const int sect = isq ? 1536 : 2048; const int hl = (u.pn - (isq ? 6 : 8)) * 4 + wc;
            const float* gp = (isq ? qgain : kgain) + 8 * fq; const float sc = isq ? QSCALE_D : 1.f;
            const int lcol = sect + hl * 64 + 8 * fq;
            f32x4 g[2][2], sw[2][2];
#pragma unroll
            for (int bj = 0; bj < 2; ++bj) { g[bj][0] = *(const f32x4*)(gp + 32 * bj) * sc; g[bj][1] = *(const f32x4*)(gp + 32 * bj + 4) * sc;
                sw[bj][0] = *(const f32x4*)(swb + lcol + 32 * bj); sw[bj][1] = *(const f32x4*)(swb + lcol + 32 * bj + 4); }
#pragma unroll
            for (int ai = 0; ai < 2; ++ai)
#pragma unroll
                for (int m = 0; m < 4; ++m) {
                    const int row = row0 + ai * HALF + m * 16;
                    const float rs = __builtin_amdgcn_rsqf(rowss[row] * (1.f / D) + EPS);
                    f32x4 v[2][2]; float ss = 0.f;
#pragma unroll
                    for (int bj = 0; bj < 2; ++bj)
#pragma unroll
                        for (int n = 0; n < 2; ++n) { v[bj][n] = acc[ai][bj][m][n] * rs + sw[bj][n]; ss += (v[bj][n][0] * v[bj][n][0] + v[bj][n][1] * v[bj][n][1]) + (v[bj][n][2] * v[bj][n][2] + v[bj][n][3] * v[bj][n][3]); }
                    ss += __shfl_xor(ss, 16); ss += __shfl_xor(ss, 32);
                    const float r = __builtin_amdgcn_rsqf(ss * (1.f / 64.f) + EPS);
                    bf16_t* rowp = O + (size_t)row * ldc + lcol;
#pragma unroll
                    for (int bj = 0; bj < 2; ++bj) { const f32x4 v0 = v[bj][0] * r * g[bj][0], v1 = v[bj][1] * r * g[bj][1];
                        u32x4 w; w.x = pk2(v0[0], v0[1]); w.y = pk2(v0[2], v0[3]); w.z = pk2(v1[0], v1[1]); w.w = pk2(v1[2], v1[3]);
                        *(u32x4*)(rowp + 32 * bj) = w; }
                }
        } else {
            const int col0 = u.pn * BM + wc * 32 + 8 * fq;
            f32x4 sw[2][2];
#pragma unroll
            for (int bj = 0; bj < 2; ++bj) { sw[bj][0] = *(const f32x4*)(swb + col0 + bj * HALF); sw[bj][1] = *(const f32x4*)(swb + col0 + bj * HALF + 4); }
#pragma unroll
            for (int ai = 0; ai < 2; ++ai)
#pragma unroll
                for (int m = 0; m < 4; ++m) { const int row = row0 + ai * HALF + m * 16;
                    const float rs = __builtin_amdgcn_rsqf(rowss[row] * (1.f / D) + EPS);
                    bf16_t* rowp = O + (size_t)row * ldc + col0;
#pragma unroll
                    for (int bj = 0; bj < 2; ++bj) { const f32x4 v0 = acc[ai][bj][m][0] * rs + sw[bj][0], v1 = acc[ai][bj][m][1] * rs + sw[bj][1];
                        u32x4 w; w.x = pk2(v0[0], v0[1]); w.y = pk2(v0[2], v0[3]); w.z = pk2(v1[0], v1[1]); w.w = pk2(v1[2], v1[3]);
                        *(u32x4*)(rowp + bj * HALF) = w; } }
        }
    }
};

struct EpiInE {
    bf16_t* O;
    __device__ __forceinline__ void operator()(const f32x4 (&acc)[2][2][4][2], const Unit& u, int wr, int wc, int fr, int fq) const {
        constexpr int ldc = LDP0;
        const int row0 = u.pm * BM + wr * 64 + fr;
        if (u.pn < 8) {
            const bool isbz = u.pn >= 4; const int cb = (isbz ? 512 : 0) + 128 * (u.pn & 3) + 16 * wc + 4 * fq;
#pragma unroll
            for (int ai = 0; ai < 2; ++ai)
#pragma unroll
                for (int m = 0; m < 4; ++m) { bf16_t* rowp = O + (size_t)(row0 + ai * HALF + m * 16) * ldc + cb;
#pragma unroll
                    for (int bj = 0; bj < 2; ++bj) { const f32x4 v0 = acc[ai][bj][m][0], v1 = acc[ai][bj][m][1];
                        f32x4 r;
                        if (isbz) { r[0] = v0[0] * silu(v1[0]); r[1] = v0[1] * silu(v1[1]); r[2] = v0[2] * silu(v1[2]); r[3] = v0[3] * silu(v1[3]); }
                        else r = v0 * v1;
                        u32x2 w; w.x = pk2(r[0], r[1]); w.y = pk2(r[2], r[3]);
                        *(u32x2*)(rowp + 64 * bj) = w; } }
        } else {
            const int col0 = u.pn * BM + wc * 32 + 8 * fq;
#pragma unroll
            for (int ai = 0; ai < 2; ++ai)
#pragma unroll
                for (int m = 0; m < 4; ++m) { bf16_t* rowp = O + (size_t)(row0 + ai * HALF + m * 16) * ldc + col0;
#pragma unroll
                    for (int bj = 0; bj < 2; ++bj) { const f32x4 v0 = acc[ai][bj][m][0], v1 = acc[ai][bj][m][1];
                        u32x4 w; w.x = pk2(v0[0], v0[1]); w.y = pk2(v0[2], v0[3]); w.z = pk2(v1[0], v1[1]); w.w = pk2(v1[2], v1[3]);
                        *(u32x4*)(rowp + bj * HALF) = w; } }
        }
    }
};

template <class Epi>
__device__ __forceinline__ void gemm_phase(LAS unsigned char* lds, const Gemm g, const StaticOrder& S, const Epi& E) {
    const int tid = opaque_tid(), wid = __builtin_amdgcn_readfirstlane(tid >> 6), lane = tid & 63, wr = wid >> 2, wc = wid & 3, fr = lane & 15, fq = lane >> 4;
    const int K = g.K, nt = K / BK, lda = g.lda;
    unsigned voffA[2], voffB[2];
#pragma unroll
    for (int i = 0; i < 2; ++i) { int R, C; stage_rc(tid * 16 + i * 8192, R, C); const int Rb = (R & ~31) + perm32(R & 31);
        voffA[i] = (unsigned)(R * lda + C) * 2u; voffB[i] = (unsigned)(Rb * K + C) * 2u; }
    const size_t kstep = (size_t)(BK * 2);
    const size_t hstepA = (size_t)HALF * lda * 2, hstepB = (size_t)HALF * K * 2;
    const size_t tstepA = 2 * hstepA, tstepB = 2 * hstepB;
    const unsigned ldsw = (unsigned)wid * 1024u;
    const int aoff = lds_byte(wr * 64 + fr, fq * 8), boff = lds_byte(wc * 32 + fr, fq * 8);
#define PG8_SA(b, h) (((b) * 2 + (h)) * HTB)
#define PG8_SB(b, h) ((4 + (b) * 2 + (h)) * HTB)
#define PG8_STAGE(bufoff, gbase, voff) do { _Pragma("unroll") for (int _i = 0; _i < 2; ++_i) \
        __builtin_amdgcn_global_load_lds((const unsigned*)((const char*)(gbase) + (voff)[_i]), (LAS unsigned*)(lds + (bufoff) + ldsw + _i * 8192), 16, 0, 0); } while (0)
#define PG8_LDA(dst, b, h) do { _Pragma("unroll") for (int m = 0; m < 4; ++m) _Pragma("unroll") for (int k = 0; k < 2; ++k) dst[m][k] = *(const LAS bf16x8*)(lds + PG8_SA(b, h) + aoff + m * 2048 + k * 1024); } while (0)
#define PG8_LDB(dst, b, h) do { _Pragma("unroll") for (int n = 0; n < 2; ++n) _Pragma("unroll") for (int k = 0; k < 2; ++k) dst[n][k] = *(const LAS bf16x8*)(lds + PG8_SB(b, h) + boff + n * 2048 + k * 1024); } while (0)
#define PG8_MMA(ai, bj, At, Bt) do { __builtin_amdgcn_s_setprio(1); _Pragma("unroll") for (int m = 0; m < 4; ++m) _Pragma("unroll") for (int n = 0; n < 2; ++n) _Pragma("unroll") for (int k = 0; k < 2; ++k) \
        acc[ai][bj][m][n] = __builtin_amdgcn_mfma_f32_16x16x32_bf16(Bt[n][k], At[m][k], acc[ai][bj][m][n], 0, 0, 0); __builtin_amdgcn_s_setprio(0); } while (0)
#define PG8_WAIT_V(n) asm volatile("s_waitcnt vmcnt(" #n ")" ::: "memory")
#define PG8_WAIT_L(n) asm volatile("s_waitcnt lgkmcnt(" #n ")" ::: "memory")
#define PG8_BAR __builtin_amdgcn_s_barrier()
#define PG8_SCHED __builtin_amdgcn_sched_barrier(0)
    Unit cur, nxt; int ui = 0;
    if (!S.next(0, cur)) return;
    f32x4 acc[2][2][4][2];
#pragma unroll
    for (int a = 0; a < 2; ++a)
#pragma unroll
        for (int b = 0; b < 2; ++b)
#pragma unroll
            for (int m = 0; m < 4; ++m)
#pragma unroll
                for (int n = 0; n < 2; ++n) acc[a][b][m][n] = (f32x4){0.f, 0.f, 0.f, 0.f};
    bf16x8 At[4][2], B0[2][2], B1[2][2];
    const char* cA = (const char*)g.A + (size_t)cur.pm * tstepA; const char* cB = (const char*)g.Bt + (size_t)cur.pn * tstepB;
    PG8_STAGE(PG8_SB(0, 0), cB, voffB); PG8_STAGE(PG8_SB(0, 1), cB + hstepB, voffB); PG8_STAGE(PG8_SA(0, 0), cA, voffA); PG8_STAGE(PG8_SA(0, 1), cA + hstepA, voffA);
    if (wr == 1) PG8_BAR;
    PG8_WAIT_V(2); PG8_BAR;
    PG8_STAGE(PG8_SB(1, 0), cB + kstep, voffB); PG8_STAGE(PG8_SA(1, 0), cA + kstep, voffA); PG8_STAGE(PG8_SB(1, 1), cB + hstepB + kstep, voffB);
    PG8_WAIT_V(6); PG8_BAR;
    for (;;) {
        const bool has_next = S.next(ui + 1, nxt);
        const char* nA = has_next ? (const char*)g.A + (size_t)nxt.pm * tstepA : cA; const char* nB = has_next ? (const char*)g.Bt + (size_t)nxt.pn * tstepB : cB;
        for (int t = 0; t < nt; t += 2) {
            const bool last = (t == nt - 2);
            const char* a1 = cA + (size_t)(t + 1) * kstep + ((t + 1) >= g.kjt ? g.kjb : 0);
            const char* a2 = last ? nA : cA + (size_t)(t + 2) * kstep + ((t + 2) >= g.kjt ? g.kjb : 0); const char* b2 = last ? nB : cB + (size_t)(t + 2) * kstep;
            const char* a3 = last ? nA + kstep : cA + (size_t)(t + 3) * kstep + ((t + 3) >= g.kjt ? g.kjb : 0); const char* b3 = b2 + kstep;
            PG8_LDB(B0, 0, 0); PG8_LDB(B1, 0, 1); PG8_SCHED; PG8_LDA(At, 0, 0); PG8_STAGE(PG8_SA(1, 1), a1 + hstepA, voffA);
            PG8_WAIT_V(8); PG8_WAIT_L(0); PG8_BAR; PG8_MMA(0, 0, At, B0); PG8_MMA(0, 1, At, B1); PG8_BAR; PG8_SCHED;
            PG8_LDA(At, 0, 1); PG8_STAGE(PG8_SB(0, 0), b2, voffB); PG8_STAGE(PG8_SB(0, 1), b2 + hstepB, voffB); PG8_STAGE(PG8_SA(0, 0), a2, voffA);
            PG8_WAIT_V(8); PG8_WAIT_L(0); PG8_BAR; PG8_MMA(1, 0, At, B0); PG8_MMA(1, 1, At, B1); PG8_BAR; PG8_SCHED;
            PG8_LDB(B0, 1, 0); PG8_LDB(B1, 1, 1); PG8_SCHED; PG8_LDA(At, 1, 0); PG8_STAGE(PG8_SA(0, 1), a2 + hstepA, voffA);
            PG8_WAIT_V(8); PG8_WAIT_L(0); PG8_BAR; PG8_MMA(0, 0, At, B0); PG8_MMA(0, 1, At, B1); PG8_BAR; PG8_SCHED;
            PG8_LDA(At, 1, 1); PG8_STAGE(PG8_SB(1, 0), b3, voffB); PG8_STAGE(PG8_SB(1, 1), b3 + hstepB, voffB); PG8_STAGE(PG8_SA(1, 0), a3, voffA);
            PG8_WAIT_V(8); PG8_WAIT_L(0); PG8_BAR; PG8_MMA(1, 0, At, B0); PG8_MMA(1, 1, At, B1); PG8_BAR; PG8_SCHED;
        }
        if (wr == 0) PG8_BAR;
        E(acc, cur, wr, wc, fr, fq);
        if (!has_next) break;
#pragma unroll
        for (int a = 0; a < 2; ++a)
#pragma unroll
            for (int b = 0; b < 2; ++b)
#pragma unroll
                for (int m = 0; m < 4; ++m)
#pragma unroll
                    for (int n = 0; n < 2; ++n) acc[a][b][m][n] = (f32x4){0.f, 0.f, 0.f, 0.f};
        cur = nxt; cA = nA; cB = nB; ++ui;
        if (wr == 1) PG8_BAR;
    }
    PG8_WAIT_V(0);
    PG8_BAR;
#undef PG8_SA
#undef PG8_SB
#undef PG8_STAGE
#undef PG8_LDA
#undef PG8_LDB
#undef PG8_MMA
#undef PG8_WAIT_V
#undef PG8_WAIT_L
#undef PG8_BAR
#undef PG8_SCHED
}
}

__device__ __forceinline__ void transpose_item(const float* W, int N, int k0, int n0, bf16_t* WT, int ldo, const float* kscale, LAS float* scr, int lane) {
#pragma unroll 8
    for (int i = 0; i < 32; ++i) { const int kk = 2 * i + (lane >> 5); float v = W[(size_t)(k0 + kk) * N + n0 + (lane & 31)]; if (kscale) v *= kscale[k0 + kk]; scr[kk * 33 + (lane & 31)] = v; }
    LDS_WAIT();
    const int c = lane & 7;
#pragma unroll
    for (int j = 0; j < 4; ++j) { const int n = (lane >> 3) + 8 * j; const LAS float* s = scr + (8 * c) * 33 + n;
        u32x4 o; o.x = pk2(s[0 * 33], s[1 * 33]); o.y = pk2(s[2 * 33], s[3 * 33]); o.z = pk2(s[4 * 33], s[5 * 33]); o.w = pk2(s[6 * 33], s[7 * 33]);
        *(u32x4*)(WT + (size_t)(n0 + n) * ldo + k0 + 8 * c) = o; }
    LDS_WAIT();
}

__device__ __forceinline__ void transpose_item2(const float* W, int N, int k0, int n0, int nd0, bf16_t* WT, int ldo, LAS float* scr, int lane) {
#pragma unroll 8
    for (int i = 0; i < 32; ++i) { const int kk = 2 * i + (lane >> 5); scr[kk * 33 + (lane & 31)] = W[(size_t)(k0 + kk) * N + n0 + (lane & 31)]; }
    LDS_WAIT();
    const int c = lane & 7;
#pragma unroll
    for (int j = 0; j < 4; ++j) { const int n = (lane >> 3) + 8 * j; const LAS float* sp = scr + (8 * c) * 33 + n;
        u32x4 o; o.x = pk2(sp[0 * 33], sp[1 * 33]); o.y = pk2(sp[2 * 33], sp[3 * 33]); o.z = pk2(sp[4 * 33], sp[5 * 33]); o.w = pk2(sp[6 * 33], sp[7 * 33]);
        *(u32x4*)(WT + (size_t)(nd0 + n) * ldo + k0 + 8 * c) = o; }
    LDS_WAIT();
}

__device__ __forceinline__ int phys_pair(int ch, int n) { return 256 * (ch >> 7) + 128 * ((ch >> 6) & 1) + 32 * ((ch >> 4) & 3) + 8 * ((ch >> 2) & 3) + 4 * n + (ch & 3); }
__device__ __forceinline__ int map_ine(int col) {
    if (col < 512) return 1024 + phys_pair(col, 0);
    if (col < 1024) return phys_pair(col - 512, 0);
    if (col < 1536) return phys_pair(col - 1024, 1);
    if (col < 2048) return 1024 + phys_pair(col - 1536, 1);
    return col;
}
__device__ __forceinline__ void transpose_item_ine(const float* W, int N, int k0, int n0, bf16_t* WT, int ldo, LAS float* scr, int lane) {
#pragma unroll 8
    for (int i = 0; i < 32; ++i) { const int kk = 2 * i + (lane >> 5); scr[kk * 33 + (lane & 31)] = W[(size_t)(k0 + kk) * N + n0 + (lane & 31)]; }
    LDS_WAIT();
    const int c = lane & 7;
#pragma unroll
    for (int j = 0; j < 4; ++j) { const int n = (lane >> 3) + 8 * j; const LAS float* sp = scr + (8 * c) * 33 + n;
        u32x4 o; o.x = pk2(sp[0 * 33], sp[1 * 33]); o.y = pk2(sp[2 * 33], sp[3 * 33]); o.z = pk2(sp[4 * 33], sp[5 * 33]); o.w = pk2(sp[6 * 33], sp[7 * 33]);
        *(u32x4*)(WT + (size_t)map_ine(n0 + n) * ldo + k0 + 8 * c) = o; }
    LDS_WAIT();
}

__device__ __forceinline__ void p0_prep(const Params& p, LAS unsigned char* lds, int vcu, int G) {
    const int tid = opaque_tid(), lane = tid & 63, wave = tid >> 6;
    unsigned char* ws = p.ws;
    if (vcu < 192) {
        const int l = vcu / 96, j0 = (vcu % 96) * 32, col = tid & 31, ks = tid >> 5;
        LAS float* sl = (LAS float*)lds;
        LAS float* red = (LAS float*)(lds + 81920);
        float* mod = (float*)(ws + WS_MOD);
        const float* wp = p.w_mod + ((size_t)l * D + ks * 64) * 3072 + j0 + col;
        for (int half = 0; half < 2; ++half) {
            __syncthreads();
            for (int idx = tid; idx < 20 * 1024; idx += 512) { const int b = half * 20 + (idx >> 10), kk = idx & 1023;
                const float c = (b < 8) ? p.cp[b * D + kk] : p.cs[(b - 8) * D + kk]; sl[idx] = silu(c); }
            __syncthreads();
            float acc[20];
#pragma unroll
            for (int b = 0; b < 20; ++b) acc[b] = 0.f;
#pragma unroll 4
            for (int k4 = 0; k4 < 16; ++k4) {
                const float w0 = wp[(size_t)(k4 * 4 + 0) * 3072], w1 = wp[(size_t)(k4 * 4 + 1) * 3072], w2 = wp[(size_t)(k4 * 4 + 2) * 3072], w3 = wp[(size_t)(k4 * 4 + 3) * 3072];
#pragma unroll
                for (int b = 0; b < 20; ++b) { const f32x4 sv = *(const LAS f32x4*)(sl + b * 1024 + ks * 64 + k4 * 4); acc[b] += (sv.x * w0 + sv.y * w1) + (sv.z * w2 + sv.w * w3); }
            }
#pragma unroll
            for (int b = 0; b < 20; ++b) red[(ks * 20 + b) * 32 + col] = acc[b];
            __syncthreads();
            for (int o = tid; o < 640; o += 512) { const int b = o >> 5, c = o & 31; float sum = 0.f;
#pragma unroll
                for (int k = 0; k < 16; ++k) sum += red[(k * 20 + b) * 32 + c];
                mod[((size_t)l * NB + half * 20 + b) * 3072 + j0 + c] = sum + p.b_mod[l * 3072 + j0 + c]; }
        }
        __syncthreads();
    }
    LAS float* scr = (LAS float*)(lds + wave * 16384);
    const int gw = vcu * 8 + wave, NGW = G * 8;
    constexpr int I_INE = 16 * 93, I_INO = 16 * 112, I_OUT = 16 * 32, I_UQ = 4 * 24, I_UKV = 2 * 32;
    constexpr int NITEMS = I_INE + I_INO + 2 * I_OUT + I_UQ + I_UKV;
    for (int it = gw; it < NITEMS; it += NGW) {
        int r = it;
        if (r < I_INE) { transpose_item_ine(p.w_in_e, 2976, (r / 93) * 64, (r % 93) * 32, (bf16_t*)(ws + WS_WINE), 1024, scr, lane); continue; } r -= I_INE;
        if (r < I_INO) { const int nl = (r % 112) * 32; int nphys = nl;
            if (nl >= 1536 && nl < 2560) { const int sb = nl < 2048 ? 1536 : 2048, loc = nl - sb, hl = loc >> 6, d32 = (loc & 63) >> 5; nphys = sb + (hl >> 2) * 256 + d32 * 128 + (hl & 3) * 32; }
            transpose_item2(p.w_in_o, 3584, (r / 112) * 64, nl, nphys, (bf16_t*)(ws + WS_WINO), 1024, scr, lane); continue; } r -= I_INO;
        if (r < I_OUT) { transpose_item(p.w_out_e, 1024, (r / 32) * 64, (r % 32) * 32, (bf16_t*)(ws + WS_WOE), 1024, nullptr, scr, lane); continue; } r -= I_OUT;
        if (r < I_OUT) { transpose_item(p.w_out_o, 1024, (r / 32) * 64, (r % 32) * 32, (bf16_t*)(ws + WS_WOO), 1024, nullptr, scr, lane); continue; } r -= I_OUT;
        if (r < I_UQ) { transpose_item(p.w_uq, 768, (r / 24) * 64, (r % 24) * 32, (bf16_t*)(ws + WS_WUQ), 256, p.q_norm, scr, lane); continue; } r -= I_UQ;
        transpose_item(p.w_ukv, 1024, (r / 32) * 64, (r % 32) * 32, (bf16_t*)(ws + WS_WUKV), 128, p.kv_norm, scr, lane);
    }
    const long gt = (long)vcu * 512 + tid, GT = (long)G * 512;
    { unsigned* z = (unsigned*)(ws + WS_WINE + (size_t)2976 * 1024 * 2); for (long i = gt; i < 96 * 1024 / 2; i += GT) z[i] = 0u; }
    { float* z = (float*)(ws + WS_ROWSS); for (long i = gt; i < M; i += GT) z[i] = 0.f; }
    { unsigned* o = (unsigned*)(ws + WS_CWS); for (long i = gt; i < 4 * 128 * 128 / 2; i += GT) o[i] = pk2(p.c_ws[2 * i], p.c_ws[2 * i + 1]); }
    { float* bt = (float*)(ws + WS_BIAS);
      for (long i = gt; i < 3 * 8 * 129; i += GT) { const int g = (int)i / (8 * 129), h = ((int)i / 129) % 8, j = (int)i % 129 - 64;
          const int d = g == 0 ? 1 : (g == 1 ? 4 : 16), rel = d * j, n = rel < 0 ? -rel : rel;
          int v = n; if (n >= 8) { v = 8 + (n >= 15) + (n >= 27) + (n >= 50) + (n >= 91) + (n >= 166) + (n >= 305) + (n >= 559); }
          const int bucket = (rel > 0 ? 16 : 0) + v; bt[i] = p.rel_bias[bucket * 8 + h] * LOG2E; } }
}

__device__ __forceinline__ void sw1_phase(const Params& p, LAS unsigned char* lds, int vcu) {
    const int tid = opaque_tid();
    if (vcu < 112) {
        const int j0 = vcu * 32, col = tid & 31, ks = tid >> 5;
        LAS float* sl = (LAS float*)lds; LAS float* red = (LAS float*)(lds + 81920);
        const float* mod1 = (const float*)(p.ws + WS_MOD) + (size_t)NB * 3072;
        float* sw = (float*)(p.ws + WS_SW);
        const float* wp = p.w_in_o + ((size_t)ks * 64) * LDP1 + j0 + col;
        for (int half = 0; half < 2; ++half) {
            __syncthreads();
            for (int idx = tid; idx < 20 * 1024; idx += 512) { const int b = half * 20 + (idx >> 10), kk = idx & 1023; sl[idx] = mod1[(size_t)b * 3072 + kk]; }
            __syncthreads();
            float acc[20];
#pragma unroll
            for (int b = 0; b < 20; ++b) acc[b] = 0.f;
#pragma unroll 4
            for (int k4 = 0; k4 < 16; ++k4) {
                const float w0 = wp[(size_t)(k4 * 4 + 0) * LDP1], w1 = wp[(size_t)(k4 * 4 + 1) * LDP1], w2 = wp[(size_t)(k4 * 4 + 2) * LDP1], w3 = wp[(size_t)(k4 * 4 + 3) * LDP1];
#pragma unroll
                for (int b = 0; b < 20; ++b) { const f32x4 sv = *(const LAS f32x4*)(sl + b * 1024 + ks * 64 + k4 * 4); acc[b] += (sv.x * w0 + sv.y * w1) + (sv.z * w2 + sv.w * w3); }
            }
#pragma unroll
            for (int b = 0; b < 20; ++b) red[(ks * 20 + b) * 32 + col] = acc[b];
            __syncthreads();
            for (int o = tid; o < 640; o += 512) { const int b = o >> 5, c = o & 31; float sum = 0.f;
#pragma unroll
                for (int k = 0; k < 16; ++k) sum += red[(k * 20 + b) * 32 + c];
                sw[(size_t)(half * 20 + b) * LDP1 + j0 + c] = sum; }
        }
        __syncthreads();
    }
}

__device__ __forceinline__ void prenorm_phase(const Params& p, int layer, int vcu, int G) {
    const int tid = opaque_tid(), lane = tid & 63, wave = tid >> 6;
    const int gw = vcu * 8 + wave, NGW = G * 8;
    const float* mod = (const float*)(p.ws + WS_MOD) + (size_t)layer * NB * 3072;
    const float* ng = p.norm_g + layer * D;
    bf16_t* H = (bf16_t*)(p.ws + WS_H);
    for (int m0 = gw; m0 < M; m0 += 2 * NGW) {
        f32x4 v[2][4]; float s[2] = {0.f, 0.f};
#pragma unroll
        for (int u = 0; u < 2; ++u) { const int m = m0 + u * NGW; if (m < M) {
            const float* xr = layer == 0 ? (m < MP ? p.xp + (size_t)m * D : p.xs + (size_t)(m - MP) * D) : p.out + (size_t)m * D;
            const f32x4* x4 = (const f32x4*)xr + lane;
#pragma unroll
            for (int j = 0; j < 4; ++j) v[u][j] = x4[64 * j]; } }
#pragma unroll
        for (int u = 0; u < 2; ++u) { const int m = m0 + u * NGW; if (m < M) {
#pragma unroll
            for (int j = 0; j < 4; ++j) s[u] += (v[u][j].x * v[u][j].x + v[u][j].y * v[u][j].y) + (v[u][j].z * v[u][j].z + v[u][j].w * v[u][j].w);
            const float rstd = __builtin_amdgcn_rsqf(wave_sum(s[u]) * (1.f / D) + EPS);
            const float* mb = mod + (size_t)bid_of(m) * 3072;
#pragma unroll
            for (int j = 0; j < 4; ++j) { const int col = 4 * (lane + 64 * j);
                const f32x4 g4 = *(const f32x4*)(ng + col), sh = *(const f32x4*)(mb + col), sc = *(const f32x4*)(mb + 1024 + col);
                const f32x4 hh = v[u][j] * rstd * g4 * (sc + 1.f) + sh;
                u32x2 o; o.x = pk2(hh.x, hh.y); o.y = pk2(hh.z, hh.w);
                *(u32x2*)(H + (size_t)m * D + col) = o; } } }
    }
}

struct MlaTok { u32x2 cq; unsigned ckv, kra, krb, qa, qb; u32x4 q8, k8, v8, bz, cx0, cx1, cx2; };
__device__ __forceinline__ void mla_prep_phase(const Params& p, int vcu, int G) {
    const int tid = opaque_tid(), lane = tid & 63, wave = tid >> 6, h = lane >> 3, j = lane & 7;
    const int gw = vcu * 8 + wave, NGW = G * 8;
    const bf16_t* P0 = (const bf16_t*)(p.ws + WS_P);
    bf16_t* QU = (bf16_t*)((unsigned char*)p.out + OUT_Q);
    bf16_t* KV = (bf16_t*)((unsigned char*)p.out + OUT_KV);
    bf16_t* Vb = (bf16_t*)(p.ws + WS_V);
    bf16_t* YC = (bf16_t*)(p.ws + WS_H);
    float qg[12], kg[12];
#pragma unroll
    for (int i = 0; i < 8; ++i) { qg[i] = p.q_gain[8 * j + i]; kg[i] = p.k_gain[8 * j + i]; }
#pragma unroll
    for (int i = 0; i < 2; ++i) { qg[8 + i] = p.q_gain[64 + 2 * j + i]; qg[10 + i] = p.q_gain[80 + 2 * j + i]; kg[8 + i] = p.k_gain[64 + 2 * j + i]; kg[10 + i] = p.k_gain[80 + 2 * j + i]; }
    float inv[2];
#pragma unroll
    for (int i = 0; i < 2; ++i) inv[i] = exp2f(-(float)(2 * j + i) * (13.287712379549449f / 16.f));
    float cw[3][8];
#pragma unroll
    for (int t = 0; t < 3; ++t)
#pragma unroll
        for (int i = 0; i < 8; ++i) cw[t][i] = p.a_conv[t * 512 + 8 * lane + i];
#define MLA_LOAD(T, m) do { const int m_ = (m); const int pos_ = m_ < MP ? (m_ & 4095) : ((m_ - MP) & 2047); const int Sb_ = m_ < MP ? 4096 : 2048; \
        const bf16_t* pr_ = P0 + (size_t)m_ * LDP0; \
        T.cq = *(const u32x2*)(pr_ + 2048 + 4 * lane); T.ckv = *(const unsigned*)(pr_ + 2304 + 2 * lane); \
        T.kra = *(const unsigned*)(pr_ + 2432 + 2 * j); T.krb = *(const unsigned*)(pr_ + 2448 + 2 * j); \
        const bf16_t* qr_ = QU + (size_t)m_ * 768 + h * 96; \
        T.q8 = *(const u32x4*)(qr_ + 8 * j); T.qa = *(const unsigned*)(qr_ + 64 + 2 * j); T.qb = *(const unsigned*)(qr_ + 80 + 2 * j); \
        const bf16_t* kv_ = KV + (size_t)m_ * 1024 + h * 128; \
        T.k8 = *(const u32x4*)(kv_ + 8 * j); T.v8 = *(const u32x4*)(kv_ + 64 + 8 * j); \
        T.bz = *(const u32x4*)(pr_ + 512 + 8 * lane); T.cx1 = *(const u32x4*)(pr_ + 8 * lane); \
        T.cx0 = *(const u32x4*)(pr_ - (pos_ > 0 ? LDP0 : 0) + 8 * lane); T.cx2 = *(const u32x4*)(pr_ + (pos_ < Sb_ - 1 ? LDP0 : 0) + 8 * lane); } while (0)
#define MLA_COMPUTE(T, m) do { const int m_ = (m); const int pos = m_ < MP ? (m_ & 4095) : ((m_ - MP) & 2047); const int Sb = m_ < MP ? 4096 : 2048; \
        bf16_t* qrow = QU + (size_t)m_ * 768 + h * 96; bf16_t* kvrow = KV + (size_t)m_ * 1024; \
        const float sq = bflo(T.cq.x) * bflo(T.cq.x) + bfhi(T.cq.x) * bfhi(T.cq.x) + bflo(T.cq.y) * bflo(T.cq.y) + bfhi(T.cq.y) * bfhi(T.cq.y); \
        const float rstd_q = __builtin_amdgcn_rsqf(wave_sum(sq) * (1.f / 256.f) + EPS); \
        const float skv = bflo(T.ckv) * bflo(T.ckv) + bfhi(T.ckv) * bfhi(T.ckv); \
        const float rstd_kv = __builtin_amdgcn_rsqf(wave_sum(skv) * (1.f / 128.f) + EPS); \
        float cs[2], sn[2]; \
        _Pragma("unroll") for (int i = 0; i < 2; ++i) { const float angf = (float)pos * inv[i]; const double a_ = (double)angf; const double n_ = rint(a_ * 0.15915494309189535); \
            const float rf = (float)(a_ - n_ * 6.283185307179586); cs[i] = __cosf(rf); sn[i] = __sinf(rf); } \
        { float x[12]; \
          x[0] = bflo(T.q8.x); x[1] = bfhi(T.q8.x); x[2] = bflo(T.q8.y); x[3] = bfhi(T.q8.y); x[4] = bflo(T.q8.z); x[5] = bfhi(T.q8.z); x[6] = bflo(T.q8.w); x[7] = bfhi(T.q8.w); \
          x[8] = bflo(T.qa); x[9] = bfhi(T.qa); x[10] = bflo(T.qb); x[11] = bfhi(T.qb); \
          float ss = 0.f; \
          _Pragma("unroll") for (int i = 0; i < 12; ++i) { x[i] *= rstd_q; ss += x[i] * x[i]; } \
          const float r = __builtin_amdgcn_rsqf(sum8(ss) * (1.f / 96.f) + EPS) * QSCALE_B; \
          _Pragma("unroll") for (int i = 0; i < 12; ++i) x[i] *= r * qg[i]; \
          const float o8 = x[8] * cs[0] - x[10] * sn[0], o10 = x[8] * sn[0] + x[10] * cs[0]; \
          const float o9 = x[9] * cs[1] - x[11] * sn[1], o11 = x[9] * sn[1] + x[11] * cs[1]; \
          u32x4 w; w.x = pk2(x[0], x[1]); w.y = pk2(x[2], x[3]); w.z = pk2(x[4], x[5]); w.w = pk2(x[6], x[7]); \
          *(u32x4*)(qrow + 8 * j) = w; *(unsigned*)(qrow + 64 + 2 * j) = pk2(o8, o9); *(unsigned*)(qrow + 80 + 2 * j) = pk2(o10, o11); } \
        { float x[12]; \
          x[0] = bflo(T.k8.x); x[1] = bfhi(T.k8.x); x[2] = bflo(T.k8.y); x[3] = bfhi(T.k8.y); x[4] = bflo(T.k8.z); x[5] = bfhi(T.k8.z); x[6] = bflo(T.k8.w); x[7] = bfhi(T.k8.w); \
          _Pragma("unroll") for (int i = 0; i < 8; ++i) x[i] *= rstd_kv; \
          x[8] = bflo(T.kra); x[9] = bfhi(T.kra); x[10] = bflo(T.krb); x[11] = bfhi(T.krb); \
          float ss = 0.f; \
          _Pragma("unroll") for (int i = 0; i < 12; ++i) ss += x[i] * x[i]; \
          const float r = __builtin_amdgcn_rsqf(sum8(ss) * (1.f / 96.f) + EPS); \
          _Pragma("unroll") for (int i = 0; i < 12; ++i) x[i] *= r * kg[i]; \
          const float o8 = x[8] * cs[0] - x[10] * sn[0], o10 = x[8] * sn[0] + x[10] * cs[0]; \
          const float o9 = x[9] * cs[1] - x[11] * sn[1], o11 = x[9] * sn[1] + x[11] * cs[1]; \
          bf16_t* krow = kvrow + h * 96; \
          u32x4 w; w.x = pk2(x[0], x[1]); w.y = pk2(x[2], x[3]); w.z = pk2(x[4], x[5]); w.w = pk2(x[6], x[7]); \
          *(u32x4*)(krow + 8 * j) = w; *(unsigned*)(krow + 64 + 2 * j) = pk2(o8, o9); *(unsigned*)(krow + 80 + 2 * j) = pk2(o10, o11); } \
        { u32x4 w; w.x = pk2(bflo(T.v8.x) * rstd_kv, bfhi(T.v8.x) * rstd_kv); w.y = pk2(bflo(T.v8.y) * rstd_kv, bfhi(T.v8.y) * rstd_kv); \
          w.z = pk2(bflo(T.v8.z) * rstd_kv, bfhi(T.v8.z) * rstd_kv); w.w = pk2(bflo(T.v8.w) * rstd_kv, bfhi(T.v8.w) * rstd_kv); \
          *(u32x4*)(Vb + (size_t)m_ * 512 + h * 64 + 8 * j) = w; } \
        { const float fp = pos > 0 ? 1.f : 0.f, fn = pos < Sb - 1 ? 1.f : 0.f; float y[8]; \
          _Pragma("unroll") for (int i = 0; i < 4; ++i) { \
              const float cvl = cw[0][2 * i] * (fp * bflo(T.cx0[i])) + cw[1][2 * i] * bflo(T.cx1[i]) + cw[2][2 * i] * (fn * bflo(T.cx2[i])); \
              const float cvh = cw[0][2 * i + 1] * (fp * bfhi(T.cx0[i])) + cw[1][2 * i + 1] * bfhi(T.cx1[i]) + cw[2][2 * i + 1] * (fn * bfhi(T.cx2[i])); \
              y[2 * i] = bflo(T.bz[i]) * cvl; y[2 * i + 1] = bfhi(T.bz[i]) * cvh; } \
          u32x4 w; w.x = pk2(y[0], y[1]); w.y = pk2(y[2], y[3]); w.z = pk2(y[4], y[5]); w.w = pk2(y[6], y[7]); \
          *(u32x4*)((bf16_t*)P0 + (size_t)m_ * LDP0 + 512 + 8 * lane) = w; } } while (0)
    MlaTok A, B;
    int m = gw;
    if (m < M) MLA_LOAD(A, m);
    for (; m < M; m += 2 * NGW) {
        const int m2 = m + NGW, m3 = m + 2 * NGW;
        if (m2 < M) { MLA_LOAD(B, m2); asm volatile("s_waitcnt vmcnt(13)" ::: "memory"); } else { VM_WAIT(); }
        MLA_COMPUTE(A, m);
        if (m2 < M) {
            if (m3 < M) { MLA_LOAD(A, m3); asm volatile("s_waitcnt vmcnt(13)" ::: "memory"); } else { VM_WAIT(); }
            MLA_COMPUTE(B, m2);
        }
    }
#undef MLA_LOAD
#undef MLA_COMPUTE
}

__device__ __forceinline__ void attn_dense_phase(const Params& p, LAS unsigned char* lds, int vcu) {
    const int tid = opaque_tid(), lane = tid & 63, wid = tid >> 6, r32 = lane & 31, hi = lane >> 5, j16 = lane & 15, g16 = lane >> 4;
    constexpr int KROW = 208, VROW = 192, KBUF = 128 * KROW, VBUF = 128 * VROW;
    const bf16_t* Qg = (const bf16_t*)((const unsigned char*)p.out + OUT_Q);
    const bf16_t* Kg = (const bf16_t*)((const unsigned char*)p.out + OUT_KV);
    const bf16_t* Vg = (const bf16_t*)(p.ws + WS_V);
    const bf16_t* P0 = (const bf16_t*)(p.ws + WS_P);
    bf16_t* YC = (bf16_t*)(p.ws + WS_H);
    LAS unsigned char* Kl = lds; LAS unsigned char* Vl = lds + 2 * KBUF;
    int krow[3], kcc[3], vrow[2], vcc[2];
#pragma unroll
    for (int i = 0; i < 3; ++i) { const int c = tid + 512 * i; krow[i] = c / 12; kcc[i] = c % 12; }
#pragma unroll
    for (int i = 0; i < 2; ++i) { const int c = tid + 512 * i; vrow[i] = c >> 3; vcc[i] = c & 7; }
    const unsigned vrd = (unsigned)(uintptr_t)Vl + (unsigned)((4 * hi + (j16 >> 2)) * VROW + (16 * (g16 & 1) + 4 * (j16 & 3)) * 2);
    for (int it = 0; it < 12; ++it) {
        int S, mb, h, qb;
        if (it < 4) { const int u = vcu + 256 * it; const int bh = u >> 4; qb = u & 15; h = bh & 7; S = 4096; mb = (bh >> 3) * 4096; }
        else { const int u = vcu + 256 * (it - 4); const int bh = u >> 3; qb = u & 7; h = bh & 7; S = 2048; mb = MP + (bh >> 3) * 2048; }
        const int mq = mb + qb * 256 + wid * 32 + r32;
        bf16x8 qf[6];
#pragma unroll
        for (int k0 = 0; k0 < 6; ++k0) qf[k0] = *(const bf16x8*)(Qg + (size_t)mq * 768 + h * 96 + k0 * 16 + hi * 8);
        f32x16 o0 = {}, o1 = {};
        float m_run = -1e30f, l_run = 0.f;
        const int NT = S >> 7;
        u32x4 kreg[3], vreg[2];
#define A_LOAD(t) do { const size_t mk = (size_t)(mb + (t) * 128); \
        _Pragma("unroll") for (int i = 0; i < 3; ++i) kreg[i] = *(const u32x4*)(Kg + (mk + krow[i]) * 1024 + h * 96 + kcc[i] * 8); \
        _Pragma("unroll") for (int i = 0; i < 2; ++i) vreg[i] = *(const u32x4*)(Vg + (mk + vrow[i]) * 512 + h * 64 + vcc[i] * 8); } while (0)
#define A_WRITE(b) do { \
        _Pragma("unroll") for (int i = 0; i < 3; ++i) *(LAS u32x4*)(Kl + (b) * KBUF + krow[i] * KROW + kcc[i] * 16) = kreg[i]; \
        _Pragma("unroll") for (int i = 0; i < 2; ++i) *(LAS u32x4*)(Vl + (b) * VBUF + vrow[i] * VROW + vcc[i] * 16) = vreg[i]; } while (0)
        A_LOAD(0); A_WRITE(0); __syncthreads();
        for (int t = 0; t < NT; ++t) {
            const int b = t & 1;
            if (t + 1 < NT) A_LOAD(t + 1);
            const LAS unsigned char* Kb = Kl + b * KBUF;
            const unsigned vb = vrd + (unsigned)(b * VBUF);
#pragma unroll
            for (int kh = 0; kh < 2; ++kh) {
                f32x16 s0 = {}, s1 = {};
#pragma unroll
                for (int k0 = 0; k0 < 6; ++k0) {
                    const bf16x8 a0 = *(const LAS bf16x8*)(Kb + (kh * 64 + r32) * KROW + (k0 * 16 + hi * 8) * 2);
                    const bf16x8 a1 = *(const LAS bf16x8*)(Kb + (kh * 64 + 32 + r32) * KROW + (k0 * 16 + hi * 8) * 2);
                    s0 = __builtin_amdgcn_mfma_f32_32x32x16_bf16(a0, qf[k0], s0, 0, 0, 0);
                    s1 = __builtin_amdgcn_mfma_f32_32x32x16_bf16(a1, qf[k0], s1, 0, 0, 0);
                }
                s16x4 tv[4][4];
                { const unsigned vbh = vb + (unsigned)(kh * 64 * VROW);
                  tv[0][0] = tr_read<0 * 16 * VROW>(vbh); tv[0][1] = tr_read<0 * 16 * VROW + 8 * VROW>(vbh); tv[0][2] = tr_read<0 * 16 * VROW + 64>(vbh); tv[0][3] = tr_read<0 * 16 * VROW + 64 + 8 * VROW>(vbh);
                  tv[1][0] = tr_read<1 * 16 * VROW>(vbh); tv[1][1] = tr_read<1 * 16 * VROW + 8 * VROW>(vbh); tv[1][2] = tr_read<1 * 16 * VROW + 64>(vbh); tv[1][3] = tr_read<1 * 16 * VROW + 64 + 8 * VROW>(vbh);
                  tv[2][0] = tr_read<2 * 16 * VROW>(vbh); tv[2][1] = tr_read<2 * 16 * VROW + 8 * VROW>(vbh); tv[2][2] = tr_read<2 * 16 * VROW + 64>(vbh); tv[2][3] = tr_read<2 * 16 * VROW + 64 + 8 * VROW>(vbh);
                  tv[3][0] = tr_read<3 * 16 * VROW>(vbh); tv[3][1] = tr_read<3 * 16 * VROW + 8 * VROW>(vbh); tv[3][2] = tr_read<3 * 16 * VROW + 64>(vbh); tv[3][3] = tr_read<3 * 16 * VROW + 64 + 8 * VROW>(vbh); }
                float mx = s0[0];
#pragma unroll
                for (int r = 1; r < 16; ++r) mx = fmaxf(mx, s0[r]);
#pragma unroll
                for (int r = 0; r < 16; ++r) mx = fmaxf(mx, s1[r]);
                mx = swap_max(mx);
                if (__any(mx > m_run)) {
                    const float mn = fmaxf(m_run, mx), alpha = fexp2(m_run - mn); m_run = mn;
                    l_run *= alpha; o0 *= alpha; o1 *= alpha;
                }
                const float mn = m_run;
                float ls = 0.f;
#pragma unroll
                for (int r = 0; r < 16; ++r) { s0[r] = fexp2(s0[r] - mn); ls += s0[r]; }
#pragma unroll
                for (int r = 0; r < 16; ++r) { s1[r] = fexp2(s1[r] - mn); ls += s1[r]; }
                l_run += ls;
                bf16x8 pf[4];
                { u32x4 w;
                  w.x = pk2(s0[0], s0[1]); w.y = pk2(s0[2], s0[3]); w.z = pk2(s0[4], s0[5]); w.w = pk2(s0[6], s0[7]); pf[0] = *(bf16x8*)&w;
                  w.x = pk2(s0[8], s0[9]); w.y = pk2(s0[10], s0[11]); w.z = pk2(s0[12], s0[13]); w.w = pk2(s0[14], s0[15]); pf[1] = *(bf16x8*)&w;
                  w.x = pk2(s1[0], s1[1]); w.y = pk2(s1[2], s1[3]); w.z = pk2(s1[4], s1[5]); w.w = pk2(s1[6], s1[7]); pf[2] = *(bf16x8*)&w;
                  w.x = pk2(s1[8], s1[9]); w.y = pk2(s1[10], s1[11]); w.z = pk2(s1[12], s1[13]); w.w = pk2(s1[14], s1[15]); pf[3] = *(bf16x8*)&w; }
                LDS_WAIT(); SBAR();
#pragma unroll
                for (int J = 0; J < 4; ++J) {
                    o0 = __builtin_amdgcn_mfma_f32_32x32x16_bf16(PK8(tv[J][0], tv[J][1]), pf[J], o0, 0, 0, 0);
                    o1 = __builtin_amdgcn_mfma_f32_32x32x16_bf16(PK8(tv[J][2], tv[J][3]), pf[J], o1, 0, 0, 0);
                }
            }
            if (t + 1 < NT) A_WRITE(b ^ 1);
            __syncthreads();
        }
#undef A_LOAD
#undef A_WRITE
        const float linv = frcp(swap_sum(l_run));
        const bf16_t* zr = P0 + (size_t)mq * LDP0 + 2464 + h * 64;
        bf16_t* yr = (bf16_t*)P0 + (size_t)mq * LDP0 + 2464 + h * 64;
#pragma unroll
        for (int db = 0; db < 2; ++db)
#pragma unroll
            for (int rg = 0; rg < 4; ++rg) {
                const int d0 = db * 32 + 8 * rg + 4 * hi;
                const u32x2 z = *(const u32x2*)(zr + d0);
                const f32x16& o = db == 0 ? o0 : o1;
                const float y0 = o[4 * rg + 0] * linv * silu(bflo(z.x)), y1 = o[4 * rg + 1] * linv * silu(bfhi(z.x));
                const float y2 = o[4 * rg + 2] * linv * silu(bflo(z.y)), y3 = o[4 * rg + 3] * linv * silu(bfhi(z.y));
                u32x2 w; w.x = pk2(y0, y1); w.y = pk2(y2, y3);
                *(u32x2*)(yr + d0) = w;
            }
    }
}

template <bool NM>
__device__ __forceinline__ void attn_dense_phase3(const Params& p, LAS unsigned char* lds, int vcu) {
    const int tid = opaque_tid(), lane = tid & 63, wid = __builtin_amdgcn_readfirstlane(tid >> 6), r32 = lane & 31, hi = lane >> 5, j16 = lane & 15, g16 = lane >> 4;
    constexpr int KROW = 208, KBUF = 64 * KROW, VBUF = 64 * 128, TBUF = KBUF + VBUF;
    const bf16_t* Qg = (const bf16_t*)((const unsigned char*)p.out + OUT_Q);
    const bf16_t* Kg = (const bf16_t*)((const unsigned char*)p.out + OUT_KV);
    const bf16_t* Vg = (const bf16_t*)(p.ws + WS_V);
    const bf16_t* P0 = (const bf16_t*)(p.ws + WS_P);
    bf16_t* YC = (bf16_t*)(p.ws + WS_H);
    const bool lowhalf = wid < 4;
    int goff[3], gstep[3], loff[3];
    { const int c0 = tid; goff[0] = (c0 / 12) * 1024 + (c0 % 12) * 8; gstep[0] = 64 * 1024; loff[0] = (c0 / 12) * KROW + (c0 % 12) * 16; }
    if (lowhalf) { const int c1 = 512 + tid; goff[1] = (c1 / 12) * 1024 + (c1 % 12) * 8; gstep[1] = 64 * 1024; loff[1] = (c1 / 12) * KROW + (c1 % 12) * 16;
                   const int v2 = 256 + tid; const int row = v2 >> 3, c = v2 & 7; goff[2] = row * 512 + c * 8; gstep[2] = 64 * 512; loff[2] = KBUF + row * 128 + ((c ^ (((row >> 1) & 1) << 2)) << 4); }
    else { const int v1 = tid - 256; const int row = v1 >> 3, c = v1 & 7; goff[1] = row * 512 + c * 8; gstep[1] = 64 * 512; loff[1] = KBUF + row * 128 + ((c ^ (((row >> 1) & 1) << 2)) << 4);
           goff[2] = 0; gstep[2] = 0; loff[2] = 0; }
    if (wid >= 4) __builtin_amdgcn_s_setprio(1);
    const int fsw = (j16 >> 3) & 1;
    const unsigned vrowb = (unsigned)(uintptr_t)lds + (unsigned)(KBUF + (4 * hi + (j16 >> 2)) * 128 + 32 * (g16 & 1) + 8 * (j16 & 3));
    const unsigned vb0 = vrowb + (unsigned)(fsw * 64), vb1 = vrowb + (unsigned)((1 - fsw) * 64);
    const LAS unsigned char* kfb = lds + r32 * KROW + hi * 16;
#pragma unroll 1
    for (int it = 0; it < 12; ++it) {
        int S, mb, h, qb;
        if (it < 4) { const int u = vcu + 256 * it; const int bh = u >> 4; qb = u & 15; h = bh & 7; S = 4096; mb = (bh >> 3) * 4096; }
        else { const int u = vcu + 256 * (it - 4); const int bh = u >> 3; qb = u & 7; h = bh & 7; S = 2048; mb = MP + (bh >> 3) * 2048; }
        const int mq = mb + qb * 256 + wid * 32 + r32;
        bf16x8 qf[6];
#pragma unroll
        for (int k0 = 0; k0 < 6; ++k0) qf[k0] = *(const bf16x8*)(Qg + (size_t)mq * 768 + h * 96 + k0 * 16 + hi * 8);
        f32x16 o0 = {}, o1 = {};
        float m_run = -1e30f, l_run = 0.f;
        const int NT = S >> 6;
        const bf16_t* gp0 = Kg + (size_t)mb * 1024 + h * 96 + goff[0];
        const bf16_t* gp1 = lowhalf ? Kg + (size_t)mb * 1024 + h * 96 + goff[1] : Vg + (size_t)mb * 512 + h * 64 + goff[1];
        const bf16_t* gp2 = Vg + (size_t)mb * 512 + h * 64 + goff[2];
        u32x4 sra[3];
#define B_LOAD(R, t) do { R[0] = *(const u32x4*)(gp0 + (size_t)(t) * gstep[0]); R[1] = *(const u32x4*)(gp1 + (size_t)(t) * gstep[1]); if (lowhalf) R[2] = *(const u32x4*)(gp2 + (size_t)(t) * gstep[2]); } while (0)
#define B_WRITE(R, bo) do { *(LAS u32x4*)(lds + (bo) + loff[0]) = R[0]; *(LAS u32x4*)(lds + (bo) + loff[1]) = R[1]; if (lowhalf) *(LAS u32x4*)(lds + (bo) + loff[2]) = R[2]; } while (0)
#define B_QK(SA, SB, bo) do { SA = (f32x16){}; SB = (f32x16){}; bf16x8 kfa[6], kfc[6]; \
        _Pragma("unroll") for (int k0 = 0; k0 < 6; ++k0) { kfa[k0] = *(const LAS bf16x8*)(kfb + (bo) + k0 * 32); kfc[k0] = *(const LAS bf16x8*)(kfb + (bo) + 32 * KROW + k0 * 32); } \
        _Pragma("unroll") for (int k0 = 0; k0 < 6; ++k0) { \
            SA = __builtin_amdgcn_mfma_f32_32x32x16_bf16(kfa[k0], qf[k0], SA, 0, 0, 0); SB = __builtin_amdgcn_mfma_f32_32x32x16_bf16(kfc[k0], qf[k0], SB, 0, 0, 0); } } while (0)
        __syncthreads();
        B_LOAD(sra, 0); B_WRITE(sra, 0); B_LOAD(sra, 1); B_WRITE(sra, TBUF); __syncthreads();
        f32x16 sa0, sa1, sb0, sb1;
        B_QK(sa0, sa1, 0);
        int bc = 0, bn = TBUF, bw = 2 * TBUF;
#define B_STAGE(C0, C1, N0, N1, t) do { \
        if ((t) + 2 < NT) B_LOAD(sra, (t) + 2); \
        s16x4 tv[4][4]; \
        { const unsigned a0 = vb0 + (unsigned)bc, a1 = vb1 + (unsigned)bc; \
          tv[0][0] = tr_read<0>(a0); tv[0][1] = tr_read<1024>(a0); tv[0][2] = tr_read<0>(a1); tv[0][3] = tr_read<1024>(a1); \
          tv[1][0] = tr_read<2048>(a0); tv[1][1] = tr_read<3072>(a0); tv[1][2] = tr_read<2048>(a1); tv[1][3] = tr_read<3072>(a1); \
          tv[2][0] = tr_read<4096>(a0); tv[2][1] = tr_read<5120>(a0); tv[2][2] = tr_read<4096>(a1); tv[2][3] = tr_read<5120>(a1); \
          tv[3][0] = tr_read<6144>(a0); tv[3][1] = tr_read<7168>(a0); tv[3][2] = tr_read<6144>(a1); tv[3][3] = tr_read<7168>(a1); } \
        bf16x8 kfa[6], kfc[6]; \
        _Pragma("unroll") for (int k0 = 0; k0 < 6; ++k0) { kfa[k0] = *(const LAS bf16x8*)(kfb + bn + k0 * 32); kfc[k0] = *(const LAS bf16x8*)(kfb + bn + 32 * KROW + k0 * 32); } \
        if (!NM) { \
        float mx = C0[0]; \
        _Pragma("unroll") for (int r = 1; r < 16; ++r) mx = fmaxf(mx, C0[r]); \
        _Pragma("unroll") for (int r = 0; r < 16; ++r) mx = fmaxf(mx, C1[r]); \
        mx = swap_max(mx); \
        if (__any(mx > m_run)) { const float mn_ = fmaxf(m_run, mx), alpha = fexp2(m_run - mn_); m_run = mn_; l_run *= alpha; o0 *= alpha; o1 *= alpha; } } \
        N0 = (f32x16){}; N1 = (f32x16){}; \
        _Pragma("unroll") for (int k0 = 0; k0 < 6; ++k0) { \
            N0 = __builtin_amdgcn_mfma_f32_32x32x16_bf16(kfa[k0], qf[k0], N0, 0, 0, 0); N1 = __builtin_amdgcn_mfma_f32_32x32x16_bf16(kfc[k0], qf[k0], N1, 0, 0, 0); } \
        const float mn = NM ? 0.f : m_run; float ls = 0.f; \
        _Pragma("unroll") for (int r = 0; r < 16; ++r) { C0[r] = NM ? fexp2(C0[r]) : fexp2(C0[r] - mn); ls += C0[r]; } \
        _Pragma("unroll") for (int r = 0; r < 16; ++r) { C1[r] = NM ? fexp2(C1[r]) : fexp2(C1[r] - mn); ls += C1[r]; } \
        l_run += ls; \
        bf16x8 pf[4]; \
        { u32x4 w; \
          w.x = pk2(C0[0], C0[1]); w.y = pk2(C0[2], C0[3]); w.z = pk2(C0[4], C0[5]); w.w = pk2(C0[6], C0[7]); pf[0] = *(bf16x8*)&w; \
          w.x = pk2(C0[8], C0[9]); w.y = pk2(C0[10], C0[11]); w.z = pk2(C0[12], C0[13]); w.w = pk2(C0[14], C0[15]); pf[1] = *(bf16x8*)&w; \
          w.x = pk2(C1[0], C1[1]); w.y = pk2(C1[2], C1[3]); w.z = pk2(C1[4], C1[5]); w.w = pk2(C1[6], C1[7]); pf[2] = *(bf16x8*)&w; \
          w.x = pk2(C1[8], C1[9]); w.y = pk2(C1[10], C1[11]); w.z = pk2(C1[12], C1[13]); w.w = pk2(C1[14], C1[15]); pf[3] = *(bf16x8*)&w; } \
        _Pragma("unroll") for (int g_ = 0; g_ < 12; ++g_) { __builtin_amdgcn_sched_group_barrier(0x008, 1, 0); __builtin_amdgcn_sched_group_barrier(0x002, 9, 0); } \
        LDS_WAIT(); SBAR(); \
        _Pragma("unroll") for (int J = 0; J < 4; ++J) { \
            o0 = __builtin_amdgcn_mfma_f32_32x32x16_bf16(PK8(tv[J][0], tv[J][1]), pf[J], o0, 0, 0, 0); \
            o1 = __builtin_amdgcn_mfma_f32_32x32x16_bf16(PK8(tv[J][2], tv[J][3]), pf[J], o1, 0, 0, 0); } \
        if ((t) + 2 < NT) B_WRITE(sra, bw); \
        __syncthreads(); \
        { const int tmp = bc; bc = bn; bn = bw; bw = tmp; } } while (0)
#pragma unroll 1
        for (int t = 0; t < NT; t += 2) {
            B_STAGE(sa0, sa1, sb0, sb1, t);
            B_STAGE(sb0, sb1, sa0, sa1, t + 1);
        }
#undef B_STAGE
#undef B_QK
#undef B_LOAD
#undef B_WRITE
        const float linv = frcp(swap_sum(l_run));
        const bf16_t* zr = P0 + (size_t)mq * LDP0 + 2464 + h * 64;
        bf16_t* yr = (bf16_t*)P0 + (size_t)mq * LDP0 + 2464 + h * 64;
#pragma unroll
        for (int db = 0; db < 2; ++db)
#pragma unroll
            for (int rg = 0; rg < 4; ++rg) {
                const int d0 = db * 32 + 8 * rg + 4 * hi;
                const u32x2 z = *(const u32x2*)(zr + d0);
                const f32x16& o = db == 0 ? o0 : o1;
                const float y0 = o[4 * rg + 0] * linv * silu(bflo(z.x)), y1 = o[4 * rg + 1] * linv * silu(bfhi(z.x));
                const float y2 = o[4 * rg + 2] * linv * silu(bflo(z.y)), y3 = o[4 * rg + 3] * linv * silu(bfhi(z.y));
                u32x2 w; w.x = pk2(y0, y1); w.y = pk2(y2, y3);
                *(u32x2*)(yr + d0) = w;
            }
    }
    __builtin_amdgcn_s_setprio(0);
}

template <bool NM>
__device__ __forceinline__ void attn_dense_phase7(const Params& p, LAS unsigned char* lds, int vcu) {
    const int tid = opaque_tid(), lane = tid & 63, wid = __builtin_amdgcn_readfirstlane(tid >> 6), r32 = lane & 31, hi = lane >> 5, j16 = lane & 15, g16 = lane >> 4;
    constexpr int KROW = 208, KBUF = 64 * KROW, VBUF = 64 * 128, TBUF = KBUF + VBUF;
    const bf16_t* Qg = (const bf16_t*)((const unsigned char*)p.out + OUT_Q);
    const bf16_t* Kg = (const bf16_t*)((const unsigned char*)p.out + OUT_KV);
    const bf16_t* Vg = (const bf16_t*)(p.ws + WS_V);
    const bf16_t* P0 = (const bf16_t*)(p.ws + WS_P);
    bf16_t* YC = (bf16_t*)(p.ws + WS_H);
    const bool lowhalf = wid < 4;
    int goff0, goff1, goff2 = 0, loff0, loff1, loff2 = 0;
    { const int c0 = tid; goff0 = (c0 / 12) * 1024 + (c0 % 12) * 8; loff0 = (c0 / 12) * KROW + (c0 % 12) * 16; }
    if (lowhalf) { const int c1 = 512 + tid; goff1 = (c1 / 12) * 1024 + (c1 % 12) * 8; loff1 = (c1 / 12) * KROW + (c1 % 12) * 16;
                   const int v2 = 256 + tid; const int row = v2 >> 3, c = v2 & 7; goff2 = row * 512 + c * 8; loff2 = KBUF + row * 128 + ((c ^ (((row >> 1) & 1) << 2)) << 4); }
    else { const int v1 = tid - 256; const int row = v1 >> 3, c = v1 & 7; goff1 = row * 512 + c * 8; loff1 = KBUF + row * 128 + ((c ^ (((row >> 1) & 1) << 2)) << 4); }
    const int fsw = (j16 >> 3) & 1;
    const unsigned vrowb = (unsigned)(uintptr_t)lds + (unsigned)(KBUF + (4 * hi + (j16 >> 2)) * 128 + 32 * (g16 & 1) + 8 * (j16 & 3));
    const unsigned vb0 = vrowb + (unsigned)(fsw * 64), vb1 = vrowb + (unsigned)((1 - fsw) * 64);
    const LAS unsigned char* kfb = lds + r32 * KROW + hi * 16;
    int S = 0, mb = 0, h = 0, qb = 0;
    bf16x8 qf[6];
    const bf16_t *gp0 = Kg, *gp1 = Kg, *gp2 = Vg;
    const int stride1 = lowhalf ? 64 * 1024 : 64 * 512;
    u32x4 sra[3];
#define U_DECODE(it_) do { const int it__ = (it_); \
        if (it__ < 4) { const int u = vcu + 256 * it__; const int bh = u >> 4; qb = u & 15; h = bh & 7; S = 4096; mb = (bh >> 3) * 4096; } \
        else { const int u = vcu + 256 * (it__ - 4); const int bh = u >> 3; qb = u & 7; h = bh & 7; S = 2048; mb = MP + (bh >> 3) * 2048; } } while (0)
#define U_PREFETCH() do { const int mq_ = mb + qb * 256 + wid * 32 + r32; \
        _Pragma("unroll") for (int k0 = 0; k0 < 6; ++k0) qf[k0] = *(const bf16x8*)(Qg + (size_t)mq_ * 768 + h * 96 + k0 * 16 + hi * 8); \
        gp0 = Kg + (size_t)mb * 1024 + h * 96 + goff0; \
        gp1 = lowhalf ? Kg + (size_t)mb * 1024 + h * 96 + goff1 : Vg + (size_t)mb * 512 + h * 64 + goff1; \
        gp2 = Vg + (size_t)mb * 512 + h * 64 + goff2; \
        B_LOAD(sra, 0); } while (0)
#define B_LOAD(R, t) do { R[0] = *(const u32x4*)gp0; R[1] = *(const u32x4*)gp1; if (lowhalf) R[2] = *(const u32x4*)gp2; gp0 += 64 * 1024; gp1 += stride1; gp2 += 64 * 512; } while (0)
#define B_WRITE(R, bo) do { *(LAS u32x4*)(lds + (bo) + loff0) = R[0]; *(LAS u32x4*)(lds + (bo) + loff1) = R[1]; if (lowhalf) *(LAS u32x4*)(lds + (bo) + loff2) = R[2]; } while (0)
#define B_QK(SA, SB, bo) do { SA = (f32x16){}; SB = (f32x16){}; bf16x8 kfa[6], kfc[6]; \
        _Pragma("unroll") for (int k0 = 0; k0 < 6; ++k0) { kfa[k0] = *(const LAS bf16x8*)(kfb + (bo) + k0 * 32); kfc[k0] = *(const LAS bf16x8*)(kfb + (bo) + 32 * KROW + k0 * 32); } \
        _Pragma("unroll") for (int k0 = 0; k0 < 6; ++k0) { \
            SA = __builtin_amdgcn_mfma_f32_32x32x16_bf16(kfa[k0], qf[k0], SA, 0, 0, 0); SB = __builtin_amdgcn_mfma_f32_32x32x16_bf16(kfc[k0], qf[k0], SB, 0, 0, 0); } } while (0)
    U_DECODE(0); U_PREFETCH();
#pragma unroll 1
    for (int it = 0; it < 12; ++it) {
        const int mb_c = mb, qb_c = qb, h_c = h;
        const int NT = S >> 6;
        f32x16 o0 = {}, o1 = {};
        float l_run = 0.f;
        __syncthreads();
        *(LAS u32x4*)(lds + 3 * TBUF + KBUF + tid * 16) = (u32x4){0u, 0u, 0u, 0u};
        B_WRITE(sra, 0); B_LOAD(sra, 1); B_WRITE(sra, TBUF); __syncthreads();
        f32x16 sa0, sa1, sb0, sb1;
        B_QK(sa0, sa1, 0);
        int bp = 3 * TBUF, bc = 0, bn = TBUF, bw = 2 * TBUF;
        bf16x8 pfa[4], pfb[4];
#pragma unroll
        for (int J = 0; J < 4; ++J) { pfa[J] = (bf16x8){0, 0, 0, 0, 0, 0, 0, 0}; pfb[J] = pfa[J]; }
#define G_STAGE(C0, C1, N0, N1, PP, PN, t) do { \
        if ((t) + 2 < NT) B_LOAD(sra, (t) + 2); \
        const unsigned va0 = vb0 + (unsigned)bp, va1 = vb1 + (unsigned)bp; \
        s16x4 tv[4][4]; \
        tv[0][0] = tr_read<0>(va0); tv[0][1] = tr_read<1024>(va0); tv[0][2] = tr_read<0>(va1); tv[0][3] = tr_read<1024>(va1); \
        tv[1][0] = tr_read<2048>(va0); tv[1][1] = tr_read<3072>(va0); tv[1][2] = tr_read<2048>(va1); tv[1][3] = tr_read<3072>(va1); \
          \
        N0 = (f32x16){}; N1 = (f32x16){}; \
        _Pragma("unroll") for (int k0 = 0; k0 < 6; ++k0) { \
            const bf16x8 ka_ = *(const LAS bf16x8*)(kfb + bn + k0 * 32), kc_ = *(const LAS bf16x8*)(kfb + bn + 32 * KROW + k0 * 32); \
            N0 = __builtin_amdgcn_mfma_f32_32x32x16_bf16(ka_, qf[k0], N0, 0, 0, 0); N1 = __builtin_amdgcn_mfma_f32_32x32x16_bf16(kc_, qf[k0], N1, 0, 0, 0); } \
        float ls = 0.f; \
        _Pragma("unroll") for (int r = 0; r < 16; ++r) { C0[r] = fexp2(C0[r]); ls += C0[r]; } \
        { u32x4 w; \
          w.x = pk2(C0[0], C0[1]); w.y = pk2(C0[2], C0[3]); w.z = pk2(C0[4], C0[5]); w.w = pk2(C0[6], C0[7]); PN[0] = *(bf16x8*)&w; \
          w.x = pk2(C0[8], C0[9]); w.y = pk2(C0[10], C0[11]); w.z = pk2(C0[12], C0[13]); w.w = pk2(C0[14], C0[15]); PN[1] = *(bf16x8*)&w; } \
        _Pragma("unroll") for (int g_ = 0; g_ < 12; ++g_) { __builtin_amdgcn_sched_group_barrier(0x008, 1, 0); __builtin_amdgcn_sched_group_barrier(0x002, 4, 0); } \
        LDS_WAIT(); SBAR(); \
          \
        tv[2][0] = tr_read<4096>(va0); tv[2][1] = tr_read<5120>(va0); tv[2][2] = tr_read<4096>(va1); tv[2][3] = tr_read<5120>(va1); \
        tv[3][0] = tr_read<6144>(va0); tv[3][1] = tr_read<7168>(va0); tv[3][2] = tr_read<6144>(va1); tv[3][3] = tr_read<7168>(va1); \
        _Pragma("unroll") for (int J = 0; J < 2; ++J) { \
            o0 = __builtin_amdgcn_mfma_f32_32x32x16_bf16(PK8(tv[J][0], tv[J][1]), PP[J], o0, 0, 0, 0); \
            o1 = __builtin_amdgcn_mfma_f32_32x32x16_bf16(PK8(tv[J][2], tv[J][3]), PP[J], o1, 0, 0, 0); } \
        _Pragma("unroll") for (int r = 0; r < 8; ++r) { C1[r] = fexp2(C1[r]); ls += C1[r]; } \
        { u32x4 w; w.x = pk2(C1[0], C1[1]); w.y = pk2(C1[2], C1[3]); w.z = pk2(C1[4], C1[5]); w.w = pk2(C1[6], C1[7]); PN[2] = *(bf16x8*)&w; } \
        _Pragma("unroll") for (int g_ = 0; g_ < 4; ++g_) { __builtin_amdgcn_sched_group_barrier(0x008, 1, 0); __builtin_amdgcn_sched_group_barrier(0x002, 5, 0); } \
        LDS_WAIT(); SBAR(); \
          \
        _Pragma("unroll") for (int J = 2; J < 4; ++J) { \
            o0 = __builtin_amdgcn_mfma_f32_32x32x16_bf16(PK8(tv[J][0], tv[J][1]), PP[J], o0, 0, 0, 0); \
            o1 = __builtin_amdgcn_mfma_f32_32x32x16_bf16(PK8(tv[J][2], tv[J][3]), PP[J], o1, 0, 0, 0); } \
        _Pragma("unroll") for (int r = 8; r < 16; ++r) { C1[r] = fexp2(C1[r]); ls += C1[r]; } \
        l_run += ls; \
        { u32x4 w; w.x = pk2(C1[8], C1[9]); w.y = pk2(C1[10], C1[11]); w.z = pk2(C1[12], C1[13]); w.w = pk2(C1[14], C1[15]); PN[3] = *(bf16x8*)&w; } \
        _Pragma("unroll") for (int g_ = 0; g_ < 4; ++g_) { __builtin_amdgcn_sched_group_barrier(0x008, 1, 0); __builtin_amdgcn_sched_group_barrier(0x002, 5, 0); } \
        SBAR(); \
        if ((t) + 2 < NT) B_WRITE(sra, bw); \
        __syncthreads(); \
        { const int tmp = bp; bp = bc; bc = bn; bn = bw; bw = tmp; } } while (0)
#pragma unroll 1
        for (int t = 0; t < NT; t += 2) {
            G_STAGE(sa0, sa1, sb0, sb1, pfb, pfa, t);
            G_STAGE(sb0, sb1, sa0, sa1, pfa, pfb, t + 1);
        }
#undef G_STAGE
        {
            const unsigned a0 = vb0 + (unsigned)bp, a1 = vb1 + (unsigned)bp;
            s16x4 tv[4][4];
            tv[0][0] = tr_read<0>(a0); tv[0][1] = tr_read<1024>(a0); tv[0][2] = tr_read<0>(a1); tv[0][3] = tr_read<1024>(a1);
            tv[1][0] = tr_read<2048>(a0); tv[1][1] = tr_read<3072>(a0); tv[1][2] = tr_read<2048>(a1); tv[1][3] = tr_read<3072>(a1);
            tv[2][0] = tr_read<4096>(a0); tv[2][1] = tr_read<5120>(a0); tv[2][2] = tr_read<4096>(a1); tv[2][3] = tr_read<5120>(a1);
            tv[3][0] = tr_read<6144>(a0); tv[3][1] = tr_read<7168>(a0); tv[3][2] = tr_read<6144>(a1); tv[3][3] = tr_read<7168>(a1);
            LDS_WAIT(); SBAR();
#pragma unroll
            for (int J = 0; J < 4; ++J) {
                o0 = __builtin_amdgcn_mfma_f32_32x32x16_bf16(PK8(tv[J][0], tv[J][1]), pfb[J], o0, 0, 0, 0);
                o1 = __builtin_amdgcn_mfma_f32_32x32x16_bf16(PK8(tv[J][2], tv[J][3]), pfb[J], o1, 0, 0, 0); }
        }
        if (it + 1 < 12) { U_DECODE(it + 1); U_PREFETCH(); }
        int mqe = mb_c + qb_c * 256 + wid * 32 + r32; asm volatile("" : "+v"(mqe));
        const float linv = frcp(swap_sum(l_run));
        const bf16_t* zr = P0 + (size_t)mqe * LDP0 + 2464 + h_c * 64;
        bf16_t* yr = (bf16_t*)P0 + (size_t)mqe * LDP0 + 2464 + h_c * 64;
#pragma unroll
        for (int db = 0; db < 2; ++db)
#pragma unroll
            for (int rg = 0; rg < 4; ++rg) {
                const int d0 = db * 32 + 8 * rg + 4 * hi;
                const u32x2 z = *(const u32x2*)(zr + d0);
                const f32x16& o = db == 0 ? o0 : o1;
                const float y0 = o[4 * rg + 0] * linv * silu(bflo(z.x)), y1 = o[4 * rg + 1] * linv * silu(bfhi(z.x));
                const float y2 = o[4 * rg + 2] * linv * silu(bflo(z.y)), y3 = o[4 * rg + 3] * linv * silu(bfhi(z.y));
                u32x2 w; w.x = pk2(y0, y1); w.y = pk2(y2, y3);
                *(u32x2*)(yr + d0) = w;
            }
    }
#undef B_QK
#undef B_LOAD
#undef B_WRITE
#undef U_DECODE
#undef U_PREFETCH
    __builtin_amdgcn_s_setprio(0);
}

__device__ __forceinline__ void odd_prep_phase(const Params& p, int vcu, int G) {
    const int tid = opaque_tid(), lane = tid & 63, wave = tid >> 6, j = lane & 7;
    const int gw = vcu * 8 + wave, NGW = G * 8;
    bf16_t* P1 = (bf16_t*)(p.ws + WS_P);
    float vg[8], vbv[8], qg[8], kg[8];
#pragma unroll
    for (int i = 0; i < 8; ++i) { vg[i] = p.vn_g[8 * lane + i]; vbv[i] = p.vn_b[8 * lane + i]; qg[i] = p.dq_gain[8 * j + i] * QSCALE_D; kg[i] = p.dk_gain[8 * j + i]; }
    for (int m = gw; m < M; m += NGW) {
        bf16_t* pr = P1 + (size_t)m * LDP1;
        const u32x4 cv = *(const u32x4*)(pr + 512 + 8 * lane), dq = *(const u32x4*)(pr + 1536 + 8 * lane), dk = *(const u32x4*)(pr + 2048 + 8 * lane);
        float x[8];
#pragma unroll
        for (int i = 0; i < 4; ++i) { x[2 * i] = gelu_t(bflo(cv[i])); x[2 * i + 1] = gelu_t(bfhi(cv[i])); }
        float s = 0.f;
#pragma unroll
        for (int i = 0; i < 8; ++i) s += x[i];
        const float mean = wave_sum(s) * (1.f / 512.f);
        float s2 = 0.f;
#pragma unroll
        for (int i = 0; i < 8; ++i) { x[i] -= mean; s2 += x[i] * x[i]; }
        const float rstd = __builtin_amdgcn_rsqf(wave_sum(s2) * (1.f / 512.f) + EPS);
        u32x4 w;
#pragma unroll
        for (int i = 0; i < 4; ++i) w[i] = pk2(x[2 * i] * rstd * vg[2 * i] + vbv[2 * i], x[2 * i + 1] * rstd * vg[2 * i + 1] + vbv[2 * i + 1]);
        *(u32x4*)(pr + 512 + 8 * lane) = w;
        float q[8], k[8]; float sq = 0.f, sk = 0.f;
#pragma unroll
        for (int i = 0; i < 4; ++i) { q[2 * i] = bflo(dq[i]); q[2 * i + 1] = bfhi(dq[i]); k[2 * i] = bflo(dk[i]); k[2 * i + 1] = bfhi(dk[i]); }
#pragma unroll
        for (int i = 0; i < 8; ++i) { sq += q[i] * q[i]; sk += k[i] * k[i]; }
        const float rq = __builtin_amdgcn_rsqf(sum8(sq) * (1.f / 64.f) + EPS), rk = __builtin_amdgcn_rsqf(sum8(sk) * (1.f / 64.f) + EPS);
        u32x4 wq, wk;
#pragma unroll
        for (int i = 0; i < 4; ++i) { wq[i] = pk2(q[2 * i] * rq * qg[2 * i], q[2 * i + 1] * rq * qg[2 * i + 1]); wk[i] = pk2(k[2 * i] * rk * kg[2 * i], k[2 * i + 1] * rk * kg[2 * i + 1]); }
        *(u32x4*)(pr + 1536 + 8 * lane) = wq; *(u32x4*)(pr + 2048 + 8 * lane) = wk;
    }
}

__device__ __forceinline__ void gmlp_phase(const Params& p, LAS unsigned char* lds, int vcu) {
    const int tid = opaque_tid(), lane = tid & 63, wid = tid >> 6, r32 = lane & 31, hi = lane >> 5, j16 = lane & 15, g16 = lane >> 4;
    constexpr int VVROW = 1088;
    const bf16_t* P1 = (const bf16_t*)(p.ws + WS_P);
    const bf16_t* Ws = (const bf16_t*)(p.ws + WS_CWS);
    bf16_t* YC = (bf16_t*)(p.ws + WS_H);
    const int g = wid >> 1, chalf = wid & 1;
    const int cbase = g * 128 + chalf * 64;
    float vg[8], vbv[8];
#pragma unroll
    for (int e = 0; e < 8; ++e) { vg[e] = p.vn_g[8 * lane + e]; vbv[e] = p.vn_b[8 * lane + e]; }
    const unsigned vrd = (unsigned)(uintptr_t)lds + (unsigned)((hi * 8 + (j16 >> 2)) * VVROW + (cbase + 16 * (g16 & 1) + 4 * (j16 & 3)) * 2);
    for (int it = 0; it < 3; ++it) {
        const int ci = vcu + 256 * it; const int m0 = ci * 128;
        __syncthreads();
#pragma unroll 4
        for (int i = 0; i < 16; ++i) { const int row = wid + 8 * i;
            const u32x4 v = *(const u32x4*)(P1 + (size_t)(m0 + row) * LDP1 + 512 + lane * 8);
            float x[8];
#pragma unroll
            for (int e = 0; e < 4; ++e) { x[2 * e] = gelu_t(bflo(v[e])); x[2 * e + 1] = gelu_t(bfhi(v[e])); }
            float sm = 0.f;
#pragma unroll
            for (int e = 0; e < 8; ++e) sm += x[e];
            const float mean = wave_sum(sm) * (1.f / 512.f);
            float s2 = 0.f;
#pragma unroll
            for (int e = 0; e < 8; ++e) { x[e] -= mean; s2 += x[e] * x[e]; }
            const float rstd = __builtin_amdgcn_rsqf(wave_sum(s2) * (1.f / 512.f) + EPS);
            u32x4 w;
#pragma unroll
            for (int e = 0; e < 4; ++e) w[e] = pk2(x[2 * e] * rstd * vg[2 * e] + vbv[2 * e], x[2 * e + 1] * rstd * vg[2 * e + 1] + vbv[2 * e + 1]);
            *(LAS u32x4*)(lds + row * VVROW + lane * 16) = w; }
        __syncthreads();
#pragma unroll 1
        for (int pb = 0; pb < 4; ++pb) {
            f32x16 a0 = {}, a1 = {};
            const bf16_t* wsr = Ws + ((size_t)g * 128 + pb * 32 + r32) * 128 + hi * 8;
#pragma unroll
            for (int ks = 0; ks < 8; ++ks) {
                const bf16x8 bfr = *(const bf16x8*)(wsr + ks * 16);
                const unsigned va = vrd + (unsigned)(ks * 16 * VVROW);
                const s16x4 t00 = tr_read<0>(va), t01 = tr_read<4 * VVROW>(va), t10 = tr_read<64>(va), t11 = tr_read<64 + 4 * VVROW>(va);
                LDS_WAIT(); SBAR();
                a0 = __builtin_amdgcn_mfma_f32_32x32x16_bf16(PK8(t00, t01), bfr, a0, 0, 0, 0);
                a1 = __builtin_amdgcn_mfma_f32_32x32x16_bf16(PK8(t10, t11), bfr, a1, 0, 0, 0);
            }
            const int pl = pb * 32 + r32; const int m = m0 + pl;
            const float bsv = p.c_bs[g * 128 + pl];
            const bf16_t* pr = P1 + (size_t)m * LDP1;
#pragma unroll
            for (int cb = 0; cb < 2; ++cb)
#pragma unroll
                for (int rg = 0; rg < 4; ++rg) {
                    const int c4 = cbase + cb * 32 + 8 * rg + 4 * hi;
                    const u32x2 cu = *(const u32x2*)(pr + c4), cz = *(const u32x2*)(pr + 1024 + c4);
                    const f32x16& a = cb == 0 ? a0 : a1;
                    const float y0 = gelu_t(bflo(cu.x)) * (a[4 * rg + 0] + bsv) * silu(bflo(cz.x)), y1 = gelu_t(bfhi(cu.x)) * (a[4 * rg + 1] + bsv) * silu(bfhi(cz.x));
                    const float y2 = gelu_t(bflo(cu.y)) * (a[4 * rg + 2] + bsv) * silu(bflo(cz.y)), y3 = gelu_t(bfhi(cu.y)) * (a[4 * rg + 3] + bsv) * silu(bfhi(cz.y));
                    u32x2 w; w.x = pk2(y0, y1); w.y = pk2(y2, y3);
                    *(u32x2*)(YC + (size_t)m * D + c4) = w;
                }
        }
    }
}

__device__ __forceinline__ void dilated_phase(const Params& p, LAS unsigned char* lds, int vcu, int G) {
    const int tid = opaque_tid(), lane = tid & 63, wid = tid >> 6, r32 = lane & 31, hi = lane >> 5, j16 = lane & 15, g16 = lane >> 4;
    constexpr int VROW = 192, VBUF = 32 * VROW;
    bf16_t* P1 = (bf16_t*)(p.ws + WS_P);
    float* LSE = (float*)(p.ws + WS_LSE);
    LAS float* bt = (LAS float*)lds;
    LAS unsigned char* vl = lds + 16384 + wid * (2 * VBUF);
    __syncthreads();
    { const float* bsrc = (const float*)(p.ws + WS_BIAS); for (int i = tid; i < 3 * 8 * 129; i += 512) bt[i] = bsrc[i]; }
    __syncthreads();
    const unsigned vrd = (unsigned)(uintptr_t)vl + (unsigned)((4 * hi + (j16 >> 2)) * VROW + (16 * (g16 & 1) + 4 * (j16 & 3)) * 2);
    const int gw = vcu * 8 + wid, NGW = G * 8;
    constexpr int NTASK = 3 * 8 * (M / 32);
#pragma unroll 1
    for (int task = gw; task < NTASK; task += NGW) {
        const int T = task % (M / 32); const int gh = task / (M / 32); const int h = gh & 7, g = gh >> 3;
        const int dsh = 2 * g;
        int mb, tt, Sb;
        if (T < 1024) { mb = (T >> 7) * 4096; tt = T & 127; Sb = 4096; } else { const int t2 = T - 1024; mb = MP + (t2 >> 6) * 2048; tt = t2 & 63; Sb = 2048; }
        const int L = Sb >> dsh, tpr = L >> 5;
        const int res = tt / tpr, u0 = (tt % tpr) * 32;
        const int tq = mb + res + ((u0 + r32) << dsh);
        bf16x8 qf[4];
#pragma unroll
        for (int k0 = 0; k0 < 4; ++k0) qf[k0] = *(const bf16x8*)(P1 + (size_t)tq * LDP1 + 1536 + h * 64 + k0 * 16 + hi * 8);
        f32x16 s[5];
        const LAS float* btg = bt + (g * 8 + h) * 129;
#pragma unroll
        for (int kb = 0; kb < 5; ++kb) {
            int ku = u0 - 64 + kb * 32 + r32; ku = ku < 0 ? 0 : (ku >= L ? L - 1 : ku);
            const bf16_t* kr = P1 + (size_t)(mb + res + (ku << dsh)) * LDP1 + 2048 + h * 64 + hi * 8;
            bf16x8 kf[4];
#pragma unroll
            for (int k0 = 0; k0 < 4; ++k0) kf[k0] = *(const bf16x8*)(kr + k0 * 16);
            f32x16 a = {};
#pragma unroll
            for (int k0 = 0; k0 < 4; ++k0) a = __builtin_amdgcn_mfma_f32_32x32x16_bf16(kf[k0], qf[k0], a, 0, 0, 0);
#pragma unroll
            for (int r = 0; r < 16; ++r) {
                const int kl = kb * 32 + crow(r, hi); const int jj = kl - r32; const int kuu = u0 - 64 + kl;
                const bool ok = (jj >= 0) && (jj <= 128) && (kuu >= 0) && (kuu < L);
                const int jc = jj < 0 ? 0 : (jj > 128 ? 128 : jj);
                a[r] = ok ? a[r] + btg[jc] : -1e30f;
            }
            s[kb] = a;
        }
        float mx = -1e30f;
#pragma unroll
        for (int kb = 0; kb < 5; ++kb)
#pragma unroll
            for (int r = 0; r < 16; ++r) mx = fmaxf(mx, s[kb][r]);
        mx = swap_max(mx);
        float ls = 0.f;
#pragma unroll
        for (int kb = 0; kb < 5; ++kb)
#pragma unroll
            for (int r = 0; r < 16; ++r) { s[kb][r] = fexp2(s[kb][r] - mx); ls += s[kb][r]; }
        ls = swap_sum(ls);
        f32x16 o0 = {}, o1 = {};
        u32x4 vreg[4];
#define D_VLOAD(kb) do { int ku = u0 - 64 + (kb) * 32 + r32; ku = ku < 0 ? 0 : (ku >= L ? L - 1 : ku); \
        const bf16_t* vr = P1 + (size_t)(mb + res + (ku << dsh)) * LDP1 + 2560 + h * 64 + hi * 8; \
        _Pragma("unroll") for (int i = 0; i < 4; ++i) vreg[i] = *(const u32x4*)(vr + i * 16); } while (0)
        D_VLOAD(0);
#pragma unroll
        for (int kb = 0; kb < 5; ++kb) {
            LAS unsigned char* vbw = vl + (kb & 1) * VBUF + r32 * VROW + hi * 16;
#pragma unroll
            for (int i = 0; i < 4; ++i) *(LAS u32x4*)(vbw + i * 32) = vreg[i];
            if (kb < 4) D_VLOAD(kb + 1);
            LDS_WAIT();
            const unsigned vb = vrd + (unsigned)((kb & 1) * VBUF);
#pragma unroll
            for (int a = 0; a < 2; ++a) {
                const unsigned vba = vb + (unsigned)(a * 16 * VROW);
                const s16x4 t00 = tr_read<0>(vba), t01 = tr_read<8 * VROW>(vba), t10 = tr_read<64>(vba), t11 = tr_read<64 + 8 * VROW>(vba);
                LDS_WAIT(); SBAR();
                u32x4 w; w.x = pk2(s[kb][8 * a + 0], s[kb][8 * a + 1]); w.y = pk2(s[kb][8 * a + 2], s[kb][8 * a + 3]); w.z = pk2(s[kb][8 * a + 4], s[kb][8 * a + 5]); w.w = pk2(s[kb][8 * a + 6], s[kb][8 * a + 7]);
                const bf16x8 pf = *(bf16x8*)&w;
                o0 = __builtin_amdgcn_mfma_f32_32x32x16_bf16(PK8(t00, t01), pf, o0, 0, 0, 0);
                o1 = __builtin_amdgcn_mfma_f32_32x32x16_bf16(PK8(t10, t11), pf, o1, 0, 0, 0);
            }
        }
#undef D_VLOAD
        const float linv = frcp(ls);
        bf16_t* orow = P1 + (size_t)tq * LDP1 + g * 512 + h * 64;
#pragma unroll
        for (int db = 0; db < 2; ++db)
#pragma unroll
            for (int rg = 0; rg < 4; ++rg) {
                const f32x16& o = db == 0 ? o0 : o1;
                u32x2 w; w.x = pk2(o[4 * rg] * linv, o[4 * rg + 1] * linv); w.y = pk2(o[4 * rg + 2] * linv, o[4 * rg + 3] * linv);
                *(u32x2*)(orow + db * 32 + 8 * rg + 4 * hi) = w;
            }
        if (hi == 0) LSE[((size_t)g * M + tq) * 8 + h] = mx + __builtin_amdgcn_logf(ls);
    }
}

template <int MODE>
__device__ __forceinline__ void dilated_phase2(const Params& p, LAS unsigned char* lds, int vcu) {
    const int tid = opaque_tid(), lane = tid & 63, wid = __builtin_amdgcn_readfirstlane(tid >> 6), r32 = lane & 31, hi = lane >> 5, j16 = lane & 15, g16 = lane >> 4;
    const int hf = wid >> 2, wq = wid & 3, t = tid & 255;
    bf16_t* P1 = (bf16_t*)(p.ws + WS_P);
    float* LSE = (float*)(p.ws + WS_LSE);
    const float* BT = (const float*)(p.ws + WS_BIAS);
    LAS unsigned char* Kl = lds + hf * 66560; LAS unsigned char* Vl = Kl + 32768; LAS float* tbl = (LAS float*)(Kl + 65536);
    const int sw = (r32 >> 1) & 7;
    const LAS unsigned char* kfp[4];
#pragma unroll
    for (int k0 = 0; k0 < 4; ++k0) kfp[k0] = Kl + (32 * wq + r32) * 128 + (((2 * k0 + hi) ^ sw) << 4);
    const int fsw = (j16 >> 3) & 1;
    const unsigned vrowb = (unsigned)(uintptr_t)Vl + (unsigned)((32 * wq + 4 * hi + (j16 >> 2)) * 128 + 32 * (g16 & 1) + 8 * (j16 & 3));
    const unsigned vb0 = vrowb + (unsigned)(fsw * 64), vb1 = vrowb + (unsigned)((1 - fsw) * 64);
    const LAS float* tb = tbl + 31 - r32 + 4 * hi;
    const int hw = vcu * 2 + hf;
    constexpr int NUNITS = (MODE == 0 ? 2 : 1) * 8 * (M / 128), NU = NUNITS / 512;
    bf16_t* YC = (bf16_t*)(p.ws + WS_H);
    bf16x8 qf[4];
#pragma unroll 1
    for (int step = 0; step <= 2 * NU; ++step) {
        const int ph = step - hf;
        if (ph >= 0 && ph < 2 * NU) {
            const int unit = hw + 512 * (ph >> 1);
            const int T4 = unit % (M / 128); const int gh = unit / (M / 128) + (MODE == 0 ? 0 : 16); const int h = gh & 7, g = gh >> 3;
            const int dsh = 2 * g;
            int mb, tt, Sb;
            if (T4 < 256) { mb = (T4 >> 5) * 4096; tt = (T4 & 31) * 4; Sb = 4096; } else { const int t2 = T4 - 256; mb = MP + (t2 >> 4) * 2048; tt = (t2 & 15) * 4; Sb = 2048; }
            const int L = Sb >> dsh, tpr = L >> 5;
            const int res = tt / tpr, u0 = (tt % tpr) * 32;
            if ((ph & 1) == 0) {
                u32x4 kreg[8], vreg[8];
#pragma unroll
                for (int i = 0; i < 8; ++i) { const int idx = t + 256 * i; const int row = idx >> 3, c = idx & 7;
                    int ku = u0 - 64 + row; ku = ku < 0 ? 0 : (ku >= L ? L - 1 : ku);
                    const bf16_t* src = P1 + (size_t)(mb + res + (ku << dsh)) * LDP1 + h * 64 + c * 8;
                    kreg[i] = *(const u32x4*)(src + 2048); vreg[i] = *(const u32x4*)(src + 2560); }
                { const int tq = mb + res + ((u0 + 32 * wq + r32) << dsh);
#pragma unroll
                  for (int k0 = 0; k0 < 4; ++k0) qf[k0] = *(const bf16x8*)(P1 + (size_t)tq * LDP1 + 1536 + h * 64 + k0 * 16 + hi * 8); }
                if (t < 191) { const int jj = t - 31; tbl[t] = (jj >= 0 && jj <= 128) ? BT[(g * 8 + h) * 129 + jj] : -1e30f; }
#pragma unroll
                for (int i = 0; i < 8; ++i) { const int idx = t + 256 * i; const int row = idx >> 3, c = idx & 7;
                    *(LAS u32x4*)(Kl + row * 128 + ((c ^ ((row >> 1) & 7)) << 4)) = kreg[i];
                    *(LAS u32x4*)(Vl + row * 128 + ((c ^ (((row >> 1) & 1) << 2)) << 4)) = vreg[i]; }
            } else {
                f32x16 s[5];
#pragma unroll
                for (int kb = 0; kb < 5; ++kb) {
                    bf16x8 kf[4];
#pragma unroll
                    for (int k0 = 0; k0 < 4; ++k0) kf[k0] = *(const LAS bf16x8*)(kfp[k0] + kb * 4096);
                    f32x16 a = {};
#pragma unroll
                    for (int k0 = 0; k0 < 4; ++k0) a = __builtin_amdgcn_mfma_f32_32x32x16_bf16(kf[k0], qf[k0], a, 0, 0, 0);
#pragma unroll
                    for (int r = 0; r < 16; ++r) a[r] += tb[kb * 32 + 8 * (r >> 2) + (r & 3)];
                    s[kb] = a;
                }
                const int klo = u0 - 64 + 32 * wq;
                if (klo < 0 || klo + 160 > L) {
#pragma unroll
                    for (int kb = 0; kb < 5; ++kb)
#pragma unroll
                        for (int r = 0; r < 16; ++r) { const int ku = klo + kb * 32 + crow(r, hi); if (ku < 0 || ku >= L) s[kb][r] = -1e30f; }
                }
                float mx = -1e30f;
#pragma unroll
                for (int kb = 0; kb < 5; ++kb)
#pragma unroll
                    for (int r = 0; r < 16; ++r) mx = fmaxf(mx, s[kb][r]);
                mx = swap_max(mx);
                float ls = 0.f;
#pragma unroll
                for (int kb = 0; kb < 5; ++kb)
#pragma unroll
                    for (int r = 0; r < 16; ++r) { s[kb][r] = fexp2(s[kb][r] - mx); ls += s[kb][r]; }
                ls = swap_sum(ls);
                f32x16 o0 = {}, o1 = {};
#define D2_BATCH(J0) do { \
                s16x4 tv[5][4]; \
                tv[0][0] = tr_read<((J0) + 0) * 2048>(vb0); tv[0][1] = tr_read<((J0) + 0) * 2048 + 1024>(vb0); tv[0][2] = tr_read<((J0) + 0) * 2048>(vb1); tv[0][3] = tr_read<((J0) + 0) * 2048 + 1024>(vb1); \
                tv[1][0] = tr_read<((J0) + 1) * 2048>(vb0); tv[1][1] = tr_read<((J0) + 1) * 2048 + 1024>(vb0); tv[1][2] = tr_read<((J0) + 1) * 2048>(vb1); tv[1][3] = tr_read<((J0) + 1) * 2048 + 1024>(vb1); \
                tv[2][0] = tr_read<((J0) + 2) * 2048>(vb0); tv[2][1] = tr_read<((J0) + 2) * 2048 + 1024>(vb0); tv[2][2] = tr_read<((J0) + 2) * 2048>(vb1); tv[2][3] = tr_read<((J0) + 2) * 2048 + 1024>(vb1); \
                tv[3][0] = tr_read<((J0) + 3) * 2048>(vb0); tv[3][1] = tr_read<((J0) + 3) * 2048 + 1024>(vb0); tv[3][2] = tr_read<((J0) + 3) * 2048>(vb1); tv[3][3] = tr_read<((J0) + 3) * 2048 + 1024>(vb1); \
                tv[4][0] = tr_read<((J0) + 4) * 2048>(vb0); tv[4][1] = tr_read<((J0) + 4) * 2048 + 1024>(vb0); tv[4][2] = tr_read<((J0) + 4) * 2048>(vb1); tv[4][3] = tr_read<((J0) + 4) * 2048 + 1024>(vb1); \
                LDS_WAIT(); SBAR(); \
                _Pragma("unroll") for (int jj = 0; jj < 5; ++jj) { const int j = (J0) + jj; const int kb = j >> 1, a8 = 8 * (j & 1); \
                    u32x4 w; w.x = pk2(s[kb][a8 + 0], s[kb][a8 + 1]); w.y = pk2(s[kb][a8 + 2], s[kb][a8 + 3]); w.z = pk2(s[kb][a8 + 4], s[kb][a8 + 5]); w.w = pk2(s[kb][a8 + 6], s[kb][a8 + 7]); \
                    const bf16x8 pf = *(bf16x8*)&w; \
                    o0 = __builtin_amdgcn_mfma_f32_32x32x16_bf16(PK8(tv[jj][0], tv[jj][1]), pf, o0, 0, 0, 0); \
                    o1 = __builtin_amdgcn_mfma_f32_32x32x16_bf16(PK8(tv[jj][2], tv[jj][3]), pf, o1, 0, 0, 0); } } while (0)
                D2_BATCH(0); D2_BATCH(5);
#undef D2_BATCH
                const float linv = frcp(ls);
                const int tq = mb + res + ((u0 + 32 * wq + r32) << dsh);
                if (MODE == 0) {
                    bf16_t* orow = P1 + (size_t)tq * LDP1 + g * 512 + h * 64;
#pragma unroll
                    for (int db = 0; db < 2; ++db)
#pragma unroll
                        for (int rg = 0; rg < 4; ++rg) {
                            const f32x16& o = db == 0 ? o0 : o1;
                            u32x2 w; w.x = pk2(o[4 * rg] * linv, o[4 * rg + 1] * linv); w.y = pk2(o[4 * rg + 2] * linv, o[4 * rg + 3] * linv);
                            *(u32x2*)(orow + db * 32 + 8 * rg + 4 * hi) = w;
                        }
                    if (hi == 0) LSE[((size_t)g * M + tq) * 8 + h] = mx + __builtin_amdgcn_logf(ls);
                } else {
                    const bf16_t* prow = P1 + (size_t)tq * LDP1 + h * 64;
                    u32x2 g0v[8], g1v[8], zv[8];
#pragma unroll
                    for (int db = 0; db < 2; ++db)
#pragma unroll
                        for (int rg = 0; rg < 4; ++rg) { const int d0 = db * 32 + 8 * rg + 4 * hi;
                            g0v[db * 4 + rg] = *(const u32x2*)(prow + d0); g1v[db * 4 + rg] = *(const u32x2*)(prow + 512 + d0); zv[db * 4 + rg] = *(const u32x2*)(prow + 3072 + d0); }
                    const float l0 = LSE[((size_t)0 * M + tq) * 8 + h], l1 = LSE[((size_t)1 * M + tq) * 8 + h], l2 = mx + __builtin_amdgcn_logf(ls);
                    const float mm = fmaxf(l0, fmaxf(l1, l2));
                    float w0 = fexp2(l0 - mm), w1 = fexp2(l1 - mm), w2 = fexp2(l2 - mm);
                    const float winv = frcp(w0 + w1 + w2); w0 *= winv; w1 *= winv; w2 *= winv * linv;
                    bf16_t* yrow = YC + (size_t)tq * D + 512 + h * 64;
#pragma unroll
                    for (int db = 0; db < 2; ++db)
#pragma unroll
                        for (int rg = 0; rg < 4; ++rg) {
                            const f32x16& o = db == 0 ? o0 : o1; const u32x2 a = g0v[db * 4 + rg], c = g1v[db * 4 + rg], z = zv[db * 4 + rg];
                            const float y0 = (w0 * bflo(a.x) + w1 * bflo(c.x) + w2 * o[4 * rg + 0]) * silu(bflo(z.x)), y1 = (w0 * bfhi(a.x) + w1 * bfhi(c.x) + w2 * o[4 * rg + 1]) * silu(bfhi(z.x));
                            const float y2 = (w0 * bflo(a.y) + w1 * bflo(c.y) + w2 * o[4 * rg + 2]) * silu(bflo(z.y)), y3 = (w0 * bfhi(a.y) + w1 * bfhi(c.y) + w2 * o[4 * rg + 3]) * silu(bfhi(z.y));
                            u32x2 w; w.x = pk2(y0, y1); w.y = pk2(y2, y3);
                            *(u32x2*)(yrow + db * 32 + 8 * rg + 4 * hi) = w;
                        }
                }
            }
        }
        __syncthreads();
    }
}

struct MrgTok { u32x4 o0, o1, o2, dz; float l0, l1, l2; };
__device__ __forceinline__ void merge_phase(const Params& p, int vcu, int G) {
    const int tid = opaque_tid(), lane = tid & 63, wave = tid >> 6, h = lane >> 3;
    const int gw = vcu * 8 + wave, NGW = G * 8;
    const bf16_t* P1 = (const bf16_t*)(p.ws + WS_P);
    const float* LSE = (const float*)(p.ws + WS_LSE);
    bf16_t* YC = (bf16_t*)(p.ws + WS_H);
#define MRG_LOAD(T, m) do { const bf16_t* pr_ = P1 + (size_t)(m) * LDP1; \
        T.o0 = *(const u32x4*)(pr_ + 8 * lane); T.o1 = *(const u32x4*)(pr_ + 512 + 8 * lane); T.o2 = *(const u32x4*)(pr_ + 1024 + 8 * lane); T.dz = *(const u32x4*)(pr_ + 3072 + 8 * lane); \
        T.l0 = LSE[((size_t)0 * M + (m)) * 8 + h]; T.l1 = LSE[((size_t)1 * M + (m)) * 8 + h]; T.l2 = LSE[((size_t)2 * M + (m)) * 8 + h]; } while (0)
#define MRG_COMPUTE(T, m) do { \
        const float mx = fmaxf(T.l0, fmaxf(T.l1, T.l2)); \
        float w0 = fexp2(T.l0 - mx), w1 = fexp2(T.l1 - mx), w2 = fexp2(T.l2 - mx); \
        const float inv = frcp(w0 + w1 + w2); w0 *= inv; w1 *= inv; w2 *= inv; \
        u32x4 w; \
        _Pragma("unroll") for (int i = 0; i < 4; ++i) { \
            const float ylo = (w0 * bflo(T.o0[i]) + w1 * bflo(T.o1[i]) + w2 * bflo(T.o2[i])) * silu(bflo(T.dz[i])); \
            const float yhi = (w0 * bfhi(T.o0[i]) + w1 * bfhi(T.o1[i]) + w2 * bfhi(T.o2[i])) * silu(bfhi(T.dz[i])); \
            w[i] = pk2(ylo, yhi); } \
        *(u32x4*)(YC + (size_t)(m) * D + 512 + 8 * lane) = w; } while (0)
    MrgTok A, B;
    int m = gw;
    if (m < M) MRG_LOAD(A, m);
    for (; m < M; m += 2 * NGW) {
        const int m2 = m + NGW, m3 = m + 2 * NGW;
        if (m2 < M) MRG_LOAD(B, m2);
        MRG_COMPUTE(A, m);
        if (m2 < M) {
            if (m3 < M) MRG_LOAD(A, m3);
            MRG_COMPUTE(B, m2);
        }
    }
#undef MRG_LOAD
#undef MRG_COMPUTE
}

__global__ void __launch_bounds__(512, 2) mega(Params p) {
    extern __shared__ __attribute__((aligned(16))) unsigned char lds_raw[];
    LAS unsigned char* lds = (LAS unsigned char*)lds_raw;
    const unsigned long long mgs = ((const unsigned long long*)__builtin_amdgcn_implicitarg_ptr())[11];
    const int G = gridDim.x, bx = blockIdx.x;
    const int vcu = (G % 8 == 0) ? (bx % 8) * (G / 8) + bx / 8 : bx;
    unsigned* bar = (unsigned*)(p.ws + WS_CTL);
    volatile LAS unsigned* xst = (volatile LAS unsigned*)(lds + (LDS_BYTES - 64));
    if (threadIdx.x < 2) xst[threadIdx.x] = 0u;
    __syncthreads();
    const XcdBarrier xb = xcd_barrier_post(bar, xst);
    unsigned char* ws = p.ws;
    if (mgs == 0x9e3779b97f4a7c15ull && threadIdx.x == 0) bar[4000] = 1u;
    bf16_t* H = (bf16_t*)(ws + WS_H);
    bf16_t* P = (bf16_t*)(ws + WS_P);
    const float* MOD = (const float*)(ws + WS_MOD);

    for (int rep = 0; rep < REP_PREP; ++rep) p0_prep(p, lds, vcu, G);
    xcd_barrier(xb);
    sw1_phase(p, lds, vcu);
    for (int rep = 0; rep < REP_PRE0; ++rep) prenorm_phase(p, 0, vcu, G);
    xcd_barrier(xb);
    for (int rep = 0; rep < REP_GEMM; ++rep) { pg8::Gemm g{H, (const bf16_t*)(ws + WS_WINE), M, 3072, 1024, 1024, 1 << 30, 0}; pg8::StaticOrder S; S.init(M, 3072, G, bx);
      pg8::EpiInE E{P}; pg8::gemm_phase(lds, g, S, E); }
    xcd_barrier(xb);
    { pg8::Gemm g{P + 2048, (const bf16_t*)(ws + WS_WUQ), M, 768, 256, LDP0, 1 << 30, 0}; pg8::StaticOrder S; S.init(M, 768, G, bx);
      pg8::EpiBf16 E{(bf16_t*)((unsigned char*)p.out + OUT_Q), 768}; pg8::gemm_phase(lds, g, S, E); }
    { pg8::Gemm g{P + 2304, (const bf16_t*)(ws + WS_WUKV), M, 1024, 128, LDP0, 1 << 30, 0}; pg8::StaticOrder S; S.init(M, 1024, G, bx);
      pg8::EpiBf16 E{(bf16_t*)((unsigned char*)p.out + OUT_KV), 1024}; pg8::gemm_phase(lds, g, S, E); }
    xcd_barrier(xb);
    mla_prep_phase(p, vcu, G);
    xcd_barrier(xb);
    {
        float gq = 0.f, gk = 0.f;
        for (int i = 0; i < 96; ++i) { gq = fmaxf(gq, fabsf(p.q_gain[i])); gk = fmaxf(gk, fabsf(p.k_gain[i])); }
        const float sbound = 96.f * gq * gk * QSCALE_B;
        for (int rep = 0; rep < REP_ATTN; ++rep) { if (sbound < 64.f) attn_dense_phase7<true>(p, lds, vcu); else attn_dense_phase3<false>(p, lds, vcu); }
    }
    xcd_barrier(xb);
    { pg8::Gemm g{P + 512, (const bf16_t*)(ws + WS_WOE), M, 1024, 1024, LDP0, 8, (2464 - 1024) * 2}; pg8::StaticOrder S; S.init(M, 1024, G, bx);
      pg8::EpiResid0 E{p.xp, p.xs, p.out, MOD, MOD + (size_t)NB * 3072, p.norm_g + D, H, (float*)(ws + WS_ROWSS)}; pg8::gemm_phase(lds, g, S, E); }
    xcd_barrier(xb);
    { pg8::Gemm g{H, (const bf16_t*)(ws + WS_WINO), M, 3584, 1024, 1024, 1 << 30, 0}; pg8::StaticOrder S; S.init(M, 3584, G, bx);
      pg8::EpiInO E{P, p.dq_gain, p.dk_gain, (const float*)(ws + WS_ROWSS), (const float*)(ws + WS_SW)}; pg8::gemm_phase(lds, g, S, E); }
    xcd_barrier(xb);
    for (int rep = 0; rep < REP_GMLP; ++rep) gmlp_phase(p, lds, vcu);
    xcd_barrier(xb);
    dilated_phase2<0>(p, lds, vcu);
    xcd_barrier(xb);
    dilated_phase2<1>(p, lds, vcu);
    xcd_barrier(xb);
    { pg8::Gemm g{H, (const bf16_t*)(ws + WS_WOO), M, 1024, 1024, 1024, 1 << 30, 0}; pg8::StaticOrder S; S.init(M, 1024, G, bx);
      pg8::EpiResid E{p.out, p.out + (size_t)MP * D, p.out, MOD + (size_t)NB * 3072 + 2048}; pg8::gemm_phase(lds, g, S, E); }
}

extern "C" void kernel_launch(void* const* d_in, const int* in_sizes, int n_in, void* d_out, int out_size, void* d_ws, size_t ws_size, hipStream_t stream) {
    static int grid = 0;
    if (grid == 0) {
        if (n_in != 25 || ws_size < WS_END || out_size != M * D) { fprintf(stderr, "kernel_launch: unexpected shapes (n_in %d, ws %zu, out %d)\n", n_in, ws_size, out_size); grid = -1; return; }
        int dev = 0, cus = 0, per_cu = 0;
        (void)hipGetDevice(&dev);
        (void)hipDeviceGetAttribute(&cus, hipDeviceAttributeMultiprocessorCount, dev);
        (void)hipFuncSetAttribute((const void*)mega, hipFuncAttributeMaxDynamicSharedMemorySize, LDS_BYTES);
        (void)hipOccupancyMaxActiveBlocksPerMultiprocessor(&per_cu, (const void*)mega, 512, LDS_BYTES);
        (void)hipGetLastError();
        grid = cus;
        fprintf(stderr, "kernel_launch: grid %d (cus %d, occupancy query %d)\n", grid, cus, per_cu);
    }
    if (grid < 0) return;
    (void)hipMemsetAsync((char*)d_ws + WS_CTL, 0, 16384, stream);
    Params p{};
    const float** f = (const float**)&p;
    for (int i = 0; i < 25; ++i) f[i] = (const float*)d_in[i];
    p.out = (float*)d_out; p.ws = (unsigned char*)d_ws; p.pad = 0ull;
    void* args[] = {&p};
    hipError_t e = hipLaunchCooperativeKernel((const void*)mega, dim3(grid), dim3(512), args, LDS_BYTES, stream);
    if (e != hipSuccess) fprintf(stderr, "kernel_launch: cooperative launch failed: %s (grid %d)\n", hipGetErrorString(e), grid);
}
```

```cpp
#include <hip/hip_runtime.h>
#include <cstdio>
#include <cstdint>

#define LAS __attribute__((address_space(3)))
typedef unsigned short bf16_t;
typedef short bf16x8 __attribute__((ext_vector_type(8)));
typedef short s16x4 __attribute__((ext_vector_type(4)));
typedef float f32x4 __attribute__((ext_vector_type(4)));
typedef float f32x16 __attribute__((ext_vector_type(16)));
typedef unsigned u32x4 __attribute__((ext_vector_type(4)));
typedef unsigned u32x2 __attribute__((ext_vector_type(2)));

constexpr int D = 1024, MP = 32768, MS = 65536, M = MP + MS, NB = 40;
constexpr int LDP0 = 3072, LDP1 = 3584;
constexpr float EPS = 1e-6f, LOG2E = 1.4426950408889634f;
constexpr float QSCALE_B = 0.10206207261596577f * LOG2E;
constexpr float QSCALE_D = 0.125f * LOG2E;
constexpr int LDS_BYTES = 147456;
#ifndef REP_PREP
#define REP_PREP 1
#endif
#ifndef REP_PRE0
#define REP_PRE0 1
#endif
#ifndef REP_GMLP
#define REP_GMLP 1
#endif
#ifndef REP_MERGE
#define REP_MERGE 1
#endif
#ifndef REP_BAR
#define REP_BAR 1
#endif
#ifndef REP_ATTN
#define REP_ATTN 1
#endif
#ifndef REP_DIL
#define REP_DIL 1
#endif
#ifndef REP_GEMM
#define REP_GEMM 1
#endif

constexpr size_t MiB = 1u << 20;
constexpr size_t WS_CTL = 0;
constexpr size_t WS_MOD = 1 * MiB;
constexpr size_t WS_WINE = 2 * MiB;
constexpr size_t WS_WINO = 8 * MiB;
constexpr size_t WS_WOE = 15 * MiB;
constexpr size_t WS_WOO = 17 * MiB;
constexpr size_t WS_WUQ = 19 * MiB;
constexpr size_t WS_WUKV = 19 * MiB + 512 * 1024;
constexpr size_t WS_CWS = 20 * MiB;
constexpr size_t WS_BIAS = 20 * MiB + 256 * 1024;
constexpr size_t WS_LSE = 21 * MiB;
constexpr size_t WS_SW = 30 * MiB;
constexpr size_t WS_ROWSS = 31 * MiB;
constexpr size_t WS_H = 32 * MiB;
constexpr size_t WS_P = 224 * MiB;
constexpr size_t WS_V = 896 * MiB;
constexpr size_t WS_END = 992 * MiB;
constexpr size_t OUT_Q = 0, OUT_KV = 144 * MiB;

struct Params {
    const float *xp, *xs, *cp, *cs, *norm_g, *w_mod, *b_mod, *rel_bias, *w_in_e, *a_conv, *q_norm, *w_uq, *kv_norm, *w_ukv,
        *q_gain, *k_gain, *w_out_e, *w_in_o, *vn_g, *vn_b, *c_ws, *c_bs, *dq_gain, *dk_gain, *w_out_o;
    float* out; unsigned char* ws; unsigned long long pad;
};

__device__ __forceinline__ unsigned pk2(float lo, float hi) { unsigned r; asm volatile("v_cvt_pk_bf16_f32 %0, %1, %2" : "=v"(r) : "v"(lo), "v"(hi)); return r; }
__device__ __forceinline__ float bflo(unsigned w) { return __uint_as_float(w << 16); }
__device__ __forceinline__ float bfhi(unsigned w) { return __uint_as_float(w & 0xffff0000u); }
__device__ __forceinline__ float wave_sum(float v) {
#pragma unroll
    for (int o = 1; o < 64; o <<= 1) v += __shfl_xor(v, o);
    return v;
}
__device__ __forceinline__ float sum8(float v) { v += __shfl_xor(v, 1); v += __shfl_xor(v, 2); v += __shfl_xor(v, 4); return v; }
__device__ __forceinline__ float fexp2(float x) { return __builtin_amdgcn_exp2f(x); }
__device__ __forceinline__ float frcp(float x) { return __builtin_amdgcn_rcpf(x); }
__device__ __forceinline__ float silu(float x) { return x * frcp(1.f + fexp2(-x * LOG2E)); }
__device__ __forceinline__ float gelu_t(float x) { const float u = 0.7978845608028654f * (x + 0.044715f * x * x * x); return x * frcp(1.f + fexp2(-2.f * LOG2E * u)); }
__device__ __forceinline__ int crow(int r, int hi) { return (r & 3) + 8 * (r >> 2) + 4 * hi; }
__device__ __forceinline__ int bid_of(int m) { return m < MP ? (m >> 12) : 8 + ((m - MP) >> 11); }
__device__ __forceinline__ float swap_max(float x) { auto rr = __builtin_amdgcn_permlane32_swap(__float_as_uint(x), __float_as_uint(x), false, false); return fmaxf(__uint_as_float(rr[0]), __uint_as_float(rr[1])); }
__device__ __forceinline__ float swap_sum(float x) { auto rr = __builtin_amdgcn_permlane32_swap(__float_as_uint(x), __float_as_uint(x), false, false); return __uint_as_float(rr[0]) + __uint_as_float(rr[1]); }
__device__ __forceinline__ int opaque_tid() { int t = threadIdx.x; asm volatile("" : "+v"(t)); return t; }
#define LDS_WAIT() asm volatile("s_waitcnt lgkmcnt(0)" ::: "memory")
#define VM_WAIT() asm volatile("s_waitcnt vmcnt(0)" ::: "memory")
#define SBAR() __builtin_amdgcn_sched_barrier(0)
template <int OFF> __device__ __forceinline__ s16x4 tr_read(unsigned addr) { s16x4 r; asm volatile("ds_read_b64_tr_b16 %0, %1 offset:%2" : "=&v"(r) : "v"(addr), "i"(OFF) : "memory"); return r; }
#define PK8(L, H) (bf16x8){L[0], L[1], L[2], L[3], H[0], H[1], H[2], H[3]}

__device__ __forceinline__ void gbar1(unsigned* bar, unsigned& gen) {
    asm volatile("s_waitcnt vmcnt(0) lgkmcnt(0)" ::: "memory");
    __syncthreads();
    if (threadIdx.x == 0) {
        __builtin_amdgcn_fence(__ATOMIC_RELEASE, "agent");
        asm volatile("s_waitcnt vmcnt(0)" ::: "memory");
        const unsigned target = (gen + 1u) * gridDim.x;
        __hip_atomic_fetch_add(bar, 1u, __ATOMIC_RELAXED, __HIP_MEMORY_SCOPE_AGENT);
        unsigned spins = 0;
        while (__hip_atomic_load(bar, __ATOMIC_RELAXED, __HIP_MEMORY_SCOPE_AGENT) < target) { __builtin_amdgcn_s_sleep(2); if (++spins > (1u << 22)) break; }
        __builtin_amdgcn_fence(__ATOMIC_ACQUIRE, "agent");
        asm volatile("s_waitcnt vmcnt(0)" ::: "memory");
    }
    ++gen;
    __syncthreads();
}

__device__ __forceinline__ void gbar(unsigned* bar, unsigned& gen) { for (int r = 0; r < REP_BAR; ++r) gbar1(bar, gen); }

#define XB_TMO      128
#define XB_XCNT(j)  (256  + 64 * (j))
#define XB_XSUB(j)  (1280 + 64 * (j))
#define XB_XGEN(j)  (2304 + 64 * (j))
#define XB_TOP      3328
#define XB_TOPGEN   3392
#define XCD_BAR_WORDS 3456
#define XB_SPIN_CAP (1u << 22)
__device__ __forceinline__ unsigned xb_ld(unsigned* p)              { return __hip_atomic_load(p, __ATOMIC_RELAXED, __HIP_MEMORY_SCOPE_AGENT); }
__device__ __forceinline__ unsigned xb_add(unsigned* p, unsigned v) { return __hip_atomic_fetch_add(p, v, __ATOMIC_RELAXED, __HIP_MEMORY_SCOPE_AGENT); }
__device__ __forceinline__ unsigned xb_xcc_id() { return (unsigned)__builtin_amdgcn_s_getreg((3 << 11) | 20) & 0xFu; }
#define XB_SPIN(cond, bar) do { unsigned _sp = 0; while (cond) { __builtin_amdgcn_s_sleep(1); \
    if ((++_sp & 255u) == 0u) { if (xb_ld(&(bar)[XB_TMO])) break; if (_sp > XB_SPIN_CAP) { atomicAdd(&(bar)[XB_TMO], 1u); break; } } } } while (0)
struct XcdBarrier { unsigned* bar; unsigned x; volatile LAS unsigned* st; };
__device__ __forceinline__ XcdBarrier xcd_barrier_post(unsigned* bar, volatile LAS unsigned* st) {
    XcdBarrier b; b.bar = bar; b.x = xb_xcc_id(); b.st = st;
    if (threadIdx.x == 0) (void)xb_add(&bar[XB_XCNT(b.x)], 1u);
    return b;
}
__device__ __forceinline__ void xcd_barrier_complete(unsigned* bar, unsigned x, unsigned& nloc, unsigned& nx) {
    const unsigned G = gridDim.x * gridDim.y * gridDim.z;
    unsigned sum, cnt, mine, sp = 0u;
    for (;;) {
        sum = 0u; cnt = 0u; mine = 0u;
#pragma unroll
        for (unsigned j = 0; j < 16; ++j) { const unsigned c = xb_ld(&bar[XB_XCNT(j)]); sum += c; cnt += (c > 0u) ? 1u : 0u; mine = (j == x) ? c : mine; }
        if (sum == G) break;
        __builtin_amdgcn_s_sleep(1);
        if ((++sp & 255u) == 0u) { if (xb_ld(&bar[XB_TMO])) break; if (sp > XB_SPIN_CAP) { atomicAdd(&bar[XB_TMO], 1u); break; } }
    }
    nloc = mine > 0u ? mine : 1u; nx = cnt > 0u ? cnt : 1u;
}
__device__ __forceinline__ void xcd_barrier(const XcdBarrier& b) {
    asm volatile("s_waitcnt vmcnt(0)" ::: "memory");
    __syncthreads();
    if (threadIdx.x == 0) {
        unsigned* bar = b.bar;
        __builtin_amdgcn_s_waitcnt(0);
        unsigned nloc = b.st[0], nx = b.st[1];
        if (nloc == 0u) { xcd_barrier_complete(bar, b.x, nloc, nx); b.st[0] = nloc; b.st[1] = nx; }
        const unsigned old = xb_add(&bar[XB_XSUB(b.x)], 1u);
        const unsigned gen = old / nloc;
        if (old + 1u == (gen + 1u) * nloc) {
            __builtin_amdgcn_fence(__ATOMIC_RELEASE, "agent");
            asm volatile("s_waitcnt vmcnt(0)" ::: "memory");
            const unsigned og = xb_add(&bar[XB_TOP], 1u);
            const unsigned tg = og / nx;
            if (og + 1u == (tg + 1u) * nx) xb_add(&bar[XB_TOPGEN], 1u);
            else XB_SPIN(xb_ld(&bar[XB_TOPGEN]) == tg, bar);
            __builtin_amdgcn_fence(__ATOMIC_ACQUIRE, "agent");
            xb_add(&bar[XB_XGEN(b.x)], 1u);
            asm volatile("s_waitcnt vmcnt(0)" ::: "memory");
        } else {
            XB_SPIN(xb_ld(&bar[XB_XGEN(b.x)]) == gen, bar);
            __builtin_amdgcn_fence(__ATOMIC_ACQUIRE, "agent");
            asm volatile("s_waitcnt vmcnt(0)" ::: "memory");
        }
    }
    __syncthreads();
}
namespace pg8 {
constexpr int BM = 256, BK = 64, HALF = 128, HTB = HALF * BK * 2, STAGE_BYTES = 8 * HTB, NXCD = 8, WGM = 8;
__device__ __forceinline__ int lds_byte(int r, int c) { const int st = (r >> 4) * 2 + (c >> 5), rr = r & 15, cc = c & 31, ob = rr * 64 + cc * 2; return st * 1024 + (ob ^ (((ob >> 9) & 1) << 5)); }
__device__ __forceinline__ void stage_rc(int b, int& R, int& C) { const int st = b / 1024, sb = b % 1024, swz = sb ^ (((sb >> 9) & 1) << 5); R = (st >> 1) * 16 + swz / 64; C = (st & 1) * 32 + (swz % 64) / 2; }
__device__ __forceinline__ int perm32(int rho) { const int n = rho >> 4, i = rho & 15; return 8 * (i >> 2) + 4 * n + (i & 3); }
struct Unit { int pm, pn; };
struct Gemm { const bf16_t* A; const bf16_t* Bt; int M, N, K, lda; int kjt, kjb; };
struct StaticOrder {
    int nM, nN, nwg, G, c;
    __device__ void init(int M_, int N_, int G_, int c_) { nM = M_ / BM; nN = N_ / BM; nwg = nM * nN; G = G_; c = c_; }
    __device__ bool next(int i, Unit& u) const {
        const long L = (long)i * G + c; if (L >= nwg) return false;
        int wgid = (int)L; { const int q = nwg / NXCD, r = nwg % NXCD, xcd = wgid % NXCD, off = wgid / NXCD; wgid = (xcd < r ? xcd * (q + 1) : r * (q + 1) + (xcd - r) * q) + off; }
        const int nig = WGM * nN, gid = wgid / nig, fm = gid * WGM, gsz = (nM - fm) < WGM ? (nM - fm) : WGM;
        u.pm = fm + ((wgid % nig) % gsz); u.pn = (wgid % nig) / gsz; return true;
    }
};
struct EpiBf16 {
    bf16_t* O; int ldc;
    __device__ __forceinline__ void operator()(const f32x4 (&acc)[2][2][4][2], const Unit& u, int wr, int wc, int fr, int fq) const {
        const int row0 = u.pm * BM + wr * 64 + fr, col0 = u.pn * BM + wc * 32 + 8 * fq;
#pragma unroll
        for (int ai = 0; ai < 2; ++ai)
#pragma unroll
            for (int m = 0; m < 4; ++m) { bf16_t* rowp = O + (size_t)(row0 + ai * HALF + m * 16) * ldc + col0;
#pragma unroll
                for (int bj = 0; bj < 2; ++bj) { const f32x4 v0 = acc[ai][bj][m][0], v1 = acc[ai][bj][m][1];
                    u32x4 w; w.x = pk2(v0[0], v0[1]); w.y = pk2(v0[2], v0[3]); w.z = pk2(v1[0], v1[1]); w.w = pk2(v1[2], v1[3]);
                    *(u32x4*)(rowp + bj * HALF) = w; } }
    }
};
struct EpiResid {
    const float* bp; const float* bs; float* out; const float* gate;
    __device__ __forceinline__ void operator()(const f32x4 (&acc)[2][2][4][2], const Unit& u, int wr, int wc, int fr, int fq) const {
        const int row0 = u.pm * BM + wr * 64 + fr, col0 = u.pn * BM + wc * 32 + 8 * fq;
        const int bid = bid_of(u.pm * BM);
        const float* gp = gate + (size_t)bid * 3072 + col0;
        f32x4 g[2][2];
#pragma unroll
        for (int bj = 0; bj < 2; ++bj) { g[bj][0] = *(const f32x4*)(gp + bj * HALF); g[bj][1] = *(const f32x4*)(gp + bj * HALF + 4); }
#pragma unroll
        for (int ai = 0; ai < 2; ++ai)
#pragma unroll
            for (int m = 0; m < 4; ++m) { const int row = row0 + ai * HALF + m * 16;
                const float* bptr = (row < MP ? bp + (size_t)row * D : bs + (size_t)(row - MP) * D) + col0; float* optr = out + (size_t)row * D + col0;
#pragma unroll
                for (int bj = 0; bj < 2; ++bj) {
                    const f32x4 b0 = *(const f32x4*)(bptr + bj * HALF), b1 = *(const f32x4*)(bptr + bj * HALF + 4);
                    *(f32x4*)(optr + bj * HALF) = b0 + g[bj][0] * acc[ai][bj][m][0]; *(f32x4*)(optr + bj * HALF + 4) = b1 + g[bj][1] * acc[ai][bj][m][1]; } }
    }
};

struct EpiResid0 {
    const float* bp; const float* bs; float* out; const float* mod0; const float* mod1; const float* ng1; bf16_t* Hx; float* rowss;
    __device__ __forceinline__ void operator()(const f32x4 (&acc)[2][2][4][2], const Unit& u, int wr, int wc, int fr, int fq) const {
        const int row0 = u.pm * BM + wr * 64 + fr, col0 = u.pn * BM + wc * 32 + 8 * fq;
        const int bid = bid_of(u.pm * BM);
        const float* gp = mod0 + (size_t)bid * 3072 + 2048 + col0;
        const float* sp = mod1 + (size_t)bid * 3072 + 1024 + col0;
        f32x4 g[2][2], gv[2][2];
#pragma unroll
        for (int bj = 0; bj < 2; ++bj)
#pragma unroll
            for (int n = 0; n < 2; ++n) { g[bj][n] = *(const f32x4*)(gp + bj * HALF + 4 * n);
                gv[bj][n] = *(const f32x4*)(ng1 + col0 + bj * HALF + 4 * n) * (*(const f32x4*)(sp + bj * HALF + 4 * n) + 1.f); }
#pragma unroll
        for (int ai = 0; ai < 2; ++ai)
#pragma unroll
            for (int m = 0; m < 4; ++m) { const int row = row0 + ai * HALF + m * 16;
                const float* bptr = (row < MP ? bp + (size_t)row * D : bs + (size_t)(row - MP) * D) + col0; float* optr = out + (size_t)row * D + col0;
                bf16_t* hptr = Hx + (size_t)row * D + col0;
                float ss = 0.f;
#pragma unroll
                for (int bj = 0; bj < 2; ++bj) {
                    const f32x4 o0 = *(const f32x4*)(bptr + bj * HALF) + g[bj][0] * acc[ai][bj][m][0], o1 = *(const f32x4*)(bptr + bj * HALF + 4) + g[bj][1] * acc[ai][bj][m][1];
                    *(f32x4*)(optr + bj * HALF) = o0; *(f32x4*)(optr + bj * HALF + 4) = o1;
                    ss += (o0[0] * o0[0] + o0[1] * o0[1]) + (o0[2] * o0[2] + o0[3] * o0[3]) + (o1[0] * o1[0] + o1[1] * o1[1]) + (o1[2] * o1[2] + o1[3] * o1[3]);
                    const f32x4 h0 = o0 * gv[bj][0], h1 = o1 * gv[bj][1];
                    u32x4 w; w.x = pk2(h0[0], h0[1]); w.y = pk2(h0[2], h0[3]); w.z = pk2(h1[0], h1[1]); w.w = pk2(h1[2], h1[3]);
                    *(u32x4*)(hptr + bj * HALF) = w; }
                ss += __shfl_xor(ss, 16); ss += __shfl_xor(ss, 32);
                if (fq == 0) atomicAdd(rowss + row, ss); }
    }
};
struct EpiInO {
    bf16_t* O; const float* qgain; const float* kgain; const float* rowss; const float* sW;
    __device__ __forceinline__ void operator()(const f32x4 (&acc)[2][2][4][2], const Unit& u, int wr, int wc, int fr, int fq) const {
        constexpr int ldc = LDP1;
        const int row0 = u.pm * BM + wr * 64 + fr;
        const float* swb = sW + (size_t)bid_of(u.pm * BM) * LDP1;
        if (u.pn >= 6 && u.pn < 10) {
            const bool isq = u.pn < 8; const int sect = isq ? 1536 : 2048; const int hl = (u.pn - (isq ? 6 : 8)) * 4 + wc;
            const float* gp = (isq ? qgain : kgain) + 8 * fq; const float sc = isq ? QSCALE_D : 1.f;
            const int lcol = sect + hl * 64 + 8 * fq;
            f32x4 g[2][2], sw[2][2];
#pragma unroll
            for (int bj = 0; bj < 2; ++bj) { g[bj][0] = *(const f32x4*)(gp + 32 * bj) * sc; g[bj][1] = *(const f32x4*)(gp + 32 * bj + 4) * sc;
                sw[bj][0] = *(const f32x4*)(swb + lcol + 32 * bj); sw[bj][1] = *(const f32x4*)(swb + lcol + 32 * bj + 4); }
#pragma unroll
            for (int ai = 0; ai < 2; ++ai)
#pragma unroll
                for (int m = 0; m < 4; ++m) {
                    const int row = row0 + ai * HALF + m * 16;
                    const float rs = __builtin_amdgcn_rsqf(rowss[row] * (1.f / D) + EPS);
                    f32x4 v[2][2]; float ss = 0.f;
#pragma unroll
                    for (int bj = 0; bj < 2; ++bj)
#pragma unroll
                        for (int n = 0; n < 2; ++n) { v[bj][n] = acc[ai][bj][m][n] * rs + sw[bj][n]; ss += (v[bj][n][0] * v[bj][n][0] + v[bj][n][1] * v[bj][n][1]) + (v[bj][n][2] * v[bj][n][2] + v[bj][n][3] * v[bj][n][3]); }
                    ss += __shfl_xor(ss, 16); ss += __shfl_xor(ss, 32);
                    const float r = __builtin_amdgcn_rsqf(ss * (1.f / 64.f) + EPS);
                    bf16_t* rowp = O + (size_t)row * ldc + lcol;
#pragma unroll
                    for (int bj = 0; bj < 2; ++bj) { const f32x4 v0 = v[bj][0] * r * g[bj][0], v1 = v[bj][1] * r * g[bj][1];
                        u32x4 w; w.x = pk2(v0[0], v0[1]); w.y = pk2(v0[2], v0[3]); w.z = pk2(v1[0], v1[1]); w.w = pk2(v1[2], v1[3]);
                        *(u32x4*)(rowp + 32 * bj) = w; }
                }
        } else {
            const int col0 = u.pn * BM + wc * 32 + 8 * fq;
            f32x4 sw[2][2];
#pragma unroll
            for (int bj = 0; bj < 2; ++bj) { sw[bj][0] = *(const f32x4*)(swb + col0 + bj * HALF); sw[bj][1] = *(const f32x4*)(swb + col0 + bj * HALF + 4); }
#pragma unroll
            for (int ai = 0; ai < 2; ++ai)
#pragma unroll
                for (int m = 0; m < 4; ++m) { const int row = row0 + ai * HALF + m * 16;
                    const float rs = __builtin_amdgcn_rsqf(rowss[row] * (1.f / D) + EPS);
                    bf16_t* rowp = O + (size_t)row * ldc + col0;
#pragma unroll
                    for (int bj = 0; bj < 2; ++bj) { const f32x4 v0 = acc[ai][bj][m][0] * rs + sw[bj][0], v1 = acc[ai][bj][m][1] * rs + sw[bj][1];
                        u32x4 w; w.x = pk2(v0[0], v0[1]); w.y = pk2(v0[2], v0[3]); w.z = pk2(v1[0], v1[1]); w.w = pk2(v1[2], v1[3]);
                        *(u32x4*)(rowp + bj * HALF) = w; } }
        }
    }
};

struct EpiInE {
    bf16_t* O;
    __device__ __forceinline__ void operator()(const f32x4 (&acc)[2][2][4][2], const Unit& u, int wr, int wc, int fr, int fq) const {
        constexpr int ldc = LDP0;
        const int row0 = u.pm * BM + wr * 64 + fr;
        if (u.pn < 8) {
            const bool isbz = u.pn >= 4; const int cb = (isbz ? 512 : 0) + 128 * (u.pn & 3) + 16 * wc + 4 * fq;
#pragma unroll
            for (int ai = 0; ai < 2; ++ai)
#pragma unroll
                for (int m = 0; m < 4; ++m) { bf16_t* rowp = O + (size_t)(row0 + ai * HALF + m * 16) * ldc + cb;
#pragma unroll
                    for (int bj = 0; bj < 2; ++bj) { const f32x4 v0 = acc[ai][bj][m][0], v1 = acc[ai][bj][m][1];
                        f32x4 r;
                        if (isbz) { r[0] = v0[0] * silu(v1[0]); r[1] = v0[1] * silu(v1[1]); r[2] = v0[2] * silu(v1[2]); r[3] = v0[3] * silu(v1[3]); }
                        else r = v0 * v1;
                        u32x2 w; w.x = pk2(r[0], r[1]); w.y = pk2(r[2], r[3]);
                        *(u32x2*)(rowp + 64 * bj) = w; } }
        } else {
            const int col0 = u.pn * BM + wc * 32 + 8 * fq;
#pragma unroll
            for (int ai = 0; ai < 2; ++ai)
#pragma unroll
                for (int m = 0; m < 4; ++m) { bf16_t* rowp = O + (size_t)(row0 + ai * HALF + m * 16) * ldc + col0;
#pragma unroll
                    for (int bj = 0; bj < 2; ++bj) { const f32x4 v0 = acc[ai][bj][m][0], v1 = acc[ai][bj][m][1];
                        u32x4 w; w.x = pk2(v0[0], v0[1]); w.y = pk2(v0[2], v0[3]); w.z = pk2(v1[0], v1[1]); w.w = pk2(v1[2], v1[3]);
                        *(u32x4*)(rowp + bj * HALF) = w; } }
        }
    }
};

template <class Epi>
__device__ __forceinline__ void gemm_phase(LAS unsigned char* lds, const Gemm g, const StaticOrder& S, const Epi& E) {
    const int tid = opaque_tid(), wid = __builtin_amdgcn_readfirstlane(tid >> 6), lane = tid & 63, wr = wid >> 2, wc = wid & 3, fr = lane & 15, fq = lane >> 4;
    const int K = g.K, nt = K / BK, lda = g.lda;
    unsigned voffA[2], voffB[2];
#pragma unroll
    for (int i = 0; i < 2; ++i) { int R, C; stage_rc(tid * 16 + i * 8192, R, C); const int Rb = (R & ~31) + perm32(R & 31);
        voffA[i] = (unsigned)(R * lda + C) * 2u; voffB[i] = (unsigned)(Rb * K + C) * 2u; }
    const size_t kstep = (size_t)(BK * 2);
    const size_t hstepA = (size_t)HALF * lda * 2, hstepB = (size_t)HALF * K * 2;
    const size_t tstepA = 2 * hstepA, tstepB = 2 * hstepB;
    const unsigned ldsw = (unsigned)wid * 1024u;
    const int aoff = lds_byte(wr * 64 + fr, fq * 8), boff = lds_byte(wc * 32 + fr, fq * 8);
#define PG8_SA(b, h) (((b) * 2 + (h)) * HTB)
#define PG8_SB(b, h) ((4 + (b) * 2 + (h)) * HTB)
#define PG8_STAGE(bufoff, gbase, voff) do { _Pragma("unroll") for (int _i = 0; _i < 2; ++_i) \
        __builtin_amdgcn_global_load_lds((const unsigned*)((const char*)(gbase) + (voff)[_i]), (LAS unsigned*)(lds + (bufoff) + ldsw + _i * 8192), 16, 0, 0); } while (0)
#define PG8_LDA(dst, b, h) do { _Pragma("unroll") for (int m = 0; m < 4; ++m) _Pragma("unroll") for (int k = 0; k < 2; ++k) dst[m][k] = *(const LAS bf16x8*)(lds + PG8_SA(b, h) + aoff + m * 2048 + k * 1024); } while (0)
#define PG8_LDB(dst, b, h) do { _Pragma("unroll") for (int n = 0; n < 2; ++n) _Pragma("unroll") for (int k = 0; k < 2; ++k) dst[n][k] = *(const LAS bf16x8*)(lds + PG8_SB(b, h) + boff + n * 2048 + k * 1024); } while (0)
#define PG8_MMA(ai, bj, At, Bt) do { __builtin_amdgcn_s_setprio(1); _Pragma("unroll") for (int m = 0; m < 4; ++m) _Pragma("unroll") for (int n = 0; n < 2; ++n) _Pragma("unroll") for (int k = 0; k < 2; ++k) \
        acc[ai][bj][m][n] = __builtin_amdgcn_mfma_f32_16x16x32_bf16(Bt[n][k], At[m][k], acc[ai][bj][m][n], 0, 0, 0); __builtin_amdgcn_s_setprio(0); } while (0)
#define PG8_WAIT_V(n) asm volatile("s_waitcnt vmcnt(" #n ")" ::: "memory")
#define PG8_WAIT_L(n) asm volatile("s_waitcnt lgkmcnt(" #n ")" ::: "memory")
#define PG8_BAR __builtin_amdgcn_s_barrier()
#define PG8_SCHED __builtin_amdgcn_sched_barrier(0)
    Unit cur, nxt; int ui = 0;
    if (!S.next(0, cur)) return;
    f32x4 acc[2][2][4][2];
#pragma unroll
    for (int a = 0; a < 2; ++a)
#pragma unroll
        for (int b = 0; b < 2; ++b)
#pragma unroll
            for (int m = 0; m < 4; ++m)
#pragma unroll
                for (int n = 0; n < 2; ++n) acc[a][b][m][n] = (f32x4){0.f, 0.f, 0.f, 0.f};
    bf16x8 At[4][2], B0[2][2], B1[2][2];
    const char* cA = (const char*)g.A + (size_t)cur.pm * tstepA; const char* cB = (const char*)g.Bt + (size_t)cur.pn * tstepB;
    PG8_STAGE(PG8_SB(0, 0), cB, voffB); PG8_STAGE(PG8_SB(0, 1), cB + hstepB, voffB); PG8_STAGE(PG8_SA(0, 0), cA, voffA); PG8_STAGE(PG8_SA(0, 1), cA + hstepA, voffA);
    if (wr == 1) PG8_BAR;
    PG8_WAIT_V(2); PG8_BAR;
    PG8_STAGE(PG8_SB(1, 0), cB + kstep, voffB); PG8_STAGE(PG8_SA(1, 0), cA + kstep, voffA); PG8_STAGE(PG8_SB(1, 1), cB + hstepB + kstep, voffB);
    PG8_WAIT_V(6); PG8_BAR;
    for (;;) {
        const bool has_next = S.next(ui + 1, nxt);
        const char* nA = has_next ? (const char*)g.A + (size_t)nxt.pm * tstepA : cA; const char* nB = has_next ? (const char*)g.Bt + (size_t)nxt.pn * tstepB : cB;
        for (int t = 0; t < nt; t += 2) {
            const bool last = (t == nt - 2);
            const char* a1 = cA + (size_t)(t + 1) * kstep + ((t + 1) >= g.kjt ? g.kjb : 0);
            const char* a2 = last ? nA : cA + (size_t)(t + 2) * kstep + ((t + 2) >= g.kjt ? g.kjb : 0); const char* b2 = last ? nB : cB + (size_t)(t + 2) * kstep;
            const char* a3 = last ? nA + kstep : cA + (size_t)(t + 3) * kstep + ((t + 3) >= g.kjt ? g.kjb : 0); const char* b3 = b2 + kstep;
            PG8_LDB(B0, 0, 0); PG8_LDB(B1, 0, 1); PG8_SCHED; PG8_LDA(At, 0, 0); PG8_STAGE(PG8_SA(1, 1), a1 + hstepA, voffA);
            PG8_WAIT_V(8); PG8_WAIT_L(0); PG8_BAR; PG8_MMA(0, 0, At, B0); PG8_MMA(0, 1, At, B1); PG8_BAR; PG8_SCHED;
            PG8_LDA(At, 0, 1); PG8_STAGE(PG8_SB(0, 0), b2, voffB); PG8_STAGE(PG8_SB(0, 1), b2 + hstepB, voffB); PG8_STAGE(PG8_SA(0, 0), a2, voffA);
            PG8_WAIT_V(8); PG8_WAIT_L(0); PG8_BAR; PG8_MMA(1, 0, At, B0); PG8_MMA(1, 1, At, B1); PG8_BAR; PG8_SCHED;
            PG8_LDB(B0, 1, 0); PG8_LDB(B1, 1, 1); PG8_SCHED; PG8_LDA(At, 1, 0); PG8_STAGE(PG8_SA(0, 1), a2 + hstepA, voffA);
            PG8_WAIT_V(8); PG8_WAIT_L(0); PG8_BAR; PG8_MMA(0, 0, At, B0); PG8_MMA(0, 1, At, B1); PG8_BAR; PG8_SCHED;
            PG8_LDA(At, 1, 1); PG8_STAGE(PG8_SB(1, 0), b3, voffB); PG8_STAGE(PG8_SB(1, 1), b3 + hstepB, voffB); PG8_STAGE(PG8_SA(1, 0), a3, voffA);
            PG8_WAIT_V(8); PG8_WAIT_L(0); PG8_BAR; PG8_MMA(1, 0, At, B0); PG8_MMA(1, 1, At, B1); PG8_BAR; PG8_SCHED;
        }
        if (wr == 0) PG8_BAR;
        E(acc, cur, wr, wc, fr, fq);
        if (!has_next) break;
#pragma unroll
        for (int a = 0; a < 2; ++a)
#pragma unroll
            for (int b = 0; b < 2; ++b)
#pragma unroll
                for (int m = 0; m < 4; ++m)
#pragma unroll
                    for (int n = 0; n < 2; ++n) acc[a][b][m][n] = (f32x4){0.f, 0.f, 0.f, 0.f};
        cur = nxt; cA = nA; cB = nB; ++ui;
        if (wr == 1) PG8_BAR;
    }
    PG8_WAIT_V(0);
    PG8_BAR;
#undef PG8_SA
#undef PG8_SB
#undef PG8_STAGE
#undef PG8_LDA
#undef PG8_LDB
#undef PG8_MMA
#undef PG8_WAIT_V
#undef PG8_WAIT_L
#undef PG8_BAR
#undef PG8_SCHED
}
}

__device__ __forceinline__ void transpose_item(const float* W, int N, int k0, int n0, bf16_t* WT, int ldo, const float* kscale, LAS float* scr, int lane) {
#pragma unroll 8
    for (int i = 0; i < 32; ++i) { const int kk = 2 * i + (lane >> 5); float v = W[(size_t)(k0 + kk) * N + n0 + (lane & 31)]; if (kscale) v *= kscale[k0 + kk]; scr[kk * 33 + (lane & 31)] = v; }
    LDS_WAIT();
    const int c = lane & 7;
#pragma unroll
    for (int j = 0; j < 4; ++j) { const int n = (lane >> 3) + 8 * j; const LAS float* s = scr + (8 * c) * 33 + n;
        u32x4 o; o.x = pk2(s[0 * 33], s[1 * 33]); o.y = pk2(s[2 * 33], s[3 * 33]); o.z = pk2(s[4 * 33], s[5 * 33]); o.w = pk2(s[6 * 33], s[7 * 33]);
        *(u32x4*)(WT + (size_t)(n0 + n) * ldo + k0 + 8 * c) = o; }
    LDS_WAIT();
}

__device__ __forceinline__ void transpose_item2(const float* W, int N, int k0, int n0, int nd0, bf16_t* WT, int ldo, LAS float* scr, int lane) {
#pragma unroll 8
    for (int i = 0; i < 32; ++i) { const int kk = 2 * i + (lane >> 5); scr[kk * 33 + (lane & 31)] = W[(size_t)(k0 + kk) * N + n0 + (lane & 31)]; }
    LDS_WAIT();
    const int c = lane & 7;
#pragma unroll
    for (int j = 0; j < 4; ++j) { const int n = (lane >> 3) + 8 * j; const LAS float* sp = scr + (8 * c) * 33 + n;
        u32x4 o; o.x = pk2(sp[0 * 33], sp[1 * 33]); o.y = pk2(sp[2 * 33], sp[3 * 33]); o.z = pk2(sp[4 * 33], sp[5 * 33]); o.w = pk2(sp[6 * 33], sp[7 * 33]);
        *(u32x4*)(WT + (size_t)(nd0 + n) * ldo + k0 + 8 * c) = o; }
    LDS_WAIT();
}

__device__ __forceinline__ int phys_pair(int ch, int n) { return 256 * (ch >> 7) + 128 * ((ch >> 6) & 1) + 32 * ((ch >> 4) & 3) + 8 * ((ch >> 2) & 3) + 4 * n + (ch & 3); }
__device__ __forceinline__ int map_ine(int col) {
    if (col < 512) return 1024 + phys_pair(col, 0);
    if (col < 1024) return phys_pair(col - 512, 0);
    if (col < 1536) return phys_pair(col - 1024, 1);
    if (col < 2048) return 1024 + phys_pair(col - 1536, 1);
    return col;
}
__device__ __forceinline__ void transpose_item_ine(const float* W, int N, int k0, int n0, bf16_t* WT, int ldo, LAS float* scr, int lane) {
#pragma unroll 8
    for (int i = 0; i < 32; ++i) { const int kk = 2 * i + (lane >> 5); scr[kk * 33 + (lane & 31)] = W[(size_t)(k0 + kk) * N + n0 + (lane & 31)]; }
    LDS_WAIT();
    const int c = lane & 7;
#pragma unroll
    for (int j = 0; j < 4; ++j) { const int n = (lane >> 3) + 8 * j; const LAS float* sp = scr + (8 * c) * 33 + n;
        u32x4 o; o.x = pk2(sp[0 * 33], sp[1 * 33]); o.y = pk2(sp[2 * 33], sp[3 * 33]); o.z = pk2(sp[4 * 33], sp[5 * 33]); o.w = pk2(sp[6 * 33], sp[7 * 33]);
        *(u32x4*)(WT + (size_t)map_ine(n0 + n) * ldo + k0 + 8 * c) = o; }
    LDS_WAIT();
}

__device__ __forceinline__ void p0_prep(const Params& p, LAS unsigned char* lds, int vcu, int G) {
    const int tid = opaque_tid(), lane = tid & 63, wave = tid >> 6;
    unsigned char* ws = p.ws;
    if (vcu < 192) {
        const int l = vcu / 96, j0 = (vcu % 96) * 32, col = tid & 31, ks = tid >> 5;
        LAS float* sl = (LAS float*)lds;
        LAS float* red = (LAS float*)(lds + 81920);
        float* mod = (float*)(ws + WS_MOD);
        const float* wp = p.w_mod + ((size_t)l * D + ks * 64) * 3072 + j0 + col;
        for (int half = 0; half < 2; ++half) {
            __syncthreads();
            for (int idx = tid; idx < 20 * 1024; idx += 512) { const int b = half * 20 + (idx >> 10), kk = idx & 1023;
                const float c = (b < 8) ? p.cp[b * D + kk] : p.cs[(b - 8) * D + kk]; sl[idx] = silu(c); }
            __syncthreads();
            float acc[20];
#pragma unroll
            for (int b = 0; b < 20; ++b) acc[b] = 0.f;
#pragma unroll 4
            for (int k4 = 0; k4 < 16; ++k4) {
                const float w0 = wp[(size_t)(k4 * 4 + 0) * 3072], w1 = wp[(size_t)(k4 * 4 + 1) * 3072], w2 = wp[(size_t)(k4 * 4 + 2) * 3072], w3 = wp[(size_t)(k4 * 4 + 3) * 3072];
#pragma unroll
                for (int b = 0; b < 20; ++b) { const f32x4 sv = *(const LAS f32x4*)(sl + b * 1024 + ks * 64 + k4 * 4); acc[b] += (sv.x * w0 + sv.y * w1) + (sv.z * w2 + sv.w * w3); }
            }
#pragma unroll
            for (int b = 0; b < 20; ++b) red[(ks * 20 + b) * 32 + col] = acc[b];
            __syncthreads();
            for (int o = tid; o < 640; o += 512) { const int b = o >> 5, c = o & 31; float sum = 0.f;
#pragma unroll
                for (int k = 0; k < 16; ++k) sum += red[(k * 20 + b) * 32 + c];
                mod[((size_t)l * NB + half * 20 + b) * 3072 + j0 + c] = sum + p.b_mod[l * 3072 + j0 + c]; }
        }
        __syncthreads();
    }
    LAS float* scr = (LAS float*)(lds + wave * 16384);
    const int gw = vcu * 8 + wave, NGW = G * 8;
    constexpr int I_INE = 16 * 93, I_INO = 16 * 112, I_OUT = 16 * 32, I_UQ = 4 * 24, I_UKV = 2 * 32;
    constexpr int NITEMS = I_INE + I_INO + 2 * I_OUT + I_UQ + I_UKV;
    for (int it = gw; it < NITEMS; it += NGW) {
        int r = it;
        if (r < I_INE) { transpose_item_ine(p.w_in_e, 2976, (r / 93) * 64, (r % 93) * 32, (bf16_t*)(ws + WS_WINE), 1024, scr, lane); continue; } r -= I_INE;
        if (r < I_INO) { const int nl = (r % 112) * 32; int nphys = nl;
            if (nl >= 1536 && nl < 2560) { const int sb = nl < 2048 ? 1536 : 2048, loc = nl - sb, hl = loc >> 6, d32 = (loc & 63) >> 5; nphys = sb + (hl >> 2) * 256 + d32 * 128 + (hl & 3) * 32; }
            transpose_item2(p.w_in_o, 3584, (r / 112) * 64, nl, nphys, (bf16_t*)(ws + WS_WINO), 1024, scr, lane); continue; } r -= I_INO;
        if (r < I_OUT) { transpose_item(p.w_out_e, 1024, (r / 32) * 64, (r % 32) * 32, (bf16_t*)(ws + WS_WOE), 1024, nullptr, scr, lane); continue; } r -= I_OUT;
        if (r < I_OUT) { transpose_item(p.w_out_o, 1024, (r / 32) * 64, (r % 32) * 32, (bf16_t*)(ws + WS_WOO), 1024, nullptr, scr, lane); continue; } r -= I_OUT;
        if (r < I_UQ) { transpose_item(p.w_uq, 768, (r / 24) * 64, (r % 24) * 32, (bf16_t*)(ws + WS_WUQ), 256, p.q_norm, scr, lane); continue; } r -= I_UQ;
        transpose_item(p.w_ukv, 1024, (r / 32) * 64, (r % 32) * 32, (bf16_t*)(ws + WS_WUKV), 128, p.kv_norm, scr, lane);
    }
    const long gt = (long)vcu * 512 + tid, GT = (long)G * 512;
    { unsigned* z = (unsigned*)(ws + WS_WINE + (size_t)2976 * 1024 * 2); for (long i = gt; i < 96 * 1024 / 2; i += GT) z[i] = 0u; }
    { float* z = (float*)(ws + WS_ROWSS); for (long i = gt; i < M; i += GT) z[i] = 0.f; }
    { unsigned* o = (unsigned*)(ws + WS_CWS); for (long i = gt; i < 4 * 128 * 128 / 2; i += GT) o[i] = pk2(p.c_ws[2 * i], p.c_ws[2 * i + 1]); }
    { float* bt = (float*)(ws + WS_BIAS);
      for (long i = gt; i < 3 * 8 * 129; i += GT) { const int g = (int)i / (8 * 129), h = ((int)i / 129) % 8, j = (int)i % 129 - 64;
          const int d = g == 0 ? 1 : (g == 1 ? 4 : 16), rel = d * j, n = rel < 0 ? -rel : rel;
          int v = n; if (n >= 8) { v = 8 + (n >= 15) + (n >= 27) + (n >= 50) + (n >= 91) + (n >= 166) + (n >= 305) + (n >= 559); }
          const int bucket = (rel > 0 ? 16 : 0) + v; bt[i] = p.rel_bias[bucket * 8 + h] * LOG2E; } }
}

__device__ __forceinline__ void sw1_phase(const Params& p, LAS unsigned char* lds, int vcu) {
    const int tid = opaque_tid();
    if (vcu < 112) {
        const int j0 = vcu * 32, col = tid & 31, ks = tid >> 5;
        LAS float* sl = (LAS float*)lds; LAS float* red = (LAS float*)(lds + 81920);
        const float* mod1 = (const float*)(p.ws + WS_MOD) + (size_t)NB * 3072;
        float* sw = (float*)(p.ws + WS_SW);
        const float* wp = p.w_in_o + ((size_t)ks * 64) * LDP1 + j0 + col;
        for (int half = 0; half < 2; ++half) {
            __syncthreads();
            for (int idx = tid; idx < 20 * 1024; idx += 512) { const int b = half * 20 + (idx >> 10), kk = idx & 1023; sl[idx] = mod1[(size_t)b * 3072 + kk]; }
            __syncthreads();
            float acc[20];
#pragma unroll
            for (int b = 0; b < 20; ++b) acc[b] = 0.f;
#pragma unroll 4
            for (int k4 = 0; k4 < 16; ++k4) {
                const float w0 = wp[(size_t)(k4 * 4 + 0) * LDP1], w1 = wp[(size_t)(k4 * 4 + 1) * LDP1], w2 = wp[(size_t)(k4 * 4 + 2) * LDP1], w3 = wp[(size_t)(k4 * 4 + 3) * LDP1];
#pragma unroll
                for (int b = 0; b < 20; ++b) { const f32x4 sv = *(const LAS f32x4*)(sl + b * 1024 + ks * 64 + k4 * 4); acc[b] += (sv.x * w0 + sv.y * w1) + (sv.z * w2 + sv.w * w3); }
            }
#pragma unroll
            for (int b = 0; b < 20; ++b) red[(ks * 20 + b) * 32 + col] = acc[b];
            __syncthreads();
            for (int o = tid; o < 640; o += 512) { const int b = o >> 5, c = o & 31; float sum = 0.f;
#pragma unroll
                for (int k = 0; k < 16; ++k) sum += red[(k * 20 + b) * 32 + c];
                sw[(size_t)(half * 20 + b) * LDP1 + j0 + c] = sum; }
        }
        __syncthreads();
    }
}

__device__ __forceinline__ void prenorm_phase(const Params& p, int layer, int vcu, int G) {
    const int tid = opaque_tid(), lane = tid & 63, wave = tid >> 6;
    const int gw = vcu * 8 + wave, NGW = G * 8;
    const float* mod = (const float*)(p.ws + WS_MOD) + (size_t)layer * NB * 3072;
    const float* ng = p.norm_g + layer * D;
    bf16_t* H = (bf16_t*)(p.ws + WS_H);
    for (int m0 = gw; m0 < M; m0 += 2 * NGW) {
        f32x4 v[2][4]; float s[2] = {0.f, 0.f};
#pragma unroll
        for (int u = 0; u < 2; ++u) { const int m = m0 + u * NGW; if (m < M) {
            const float* xr = layer == 0 ? (m < MP ? p.xp + (size_t)m * D : p.xs + (size_t)(m - MP) * D) : p.out + (size_t)m * D;
            const f32x4* x4 = (const f32x4*)xr + lane;
#pragma unroll
            for (int j = 0; j < 4; ++j) v[u][j] = x4[64 * j]; } }
#pragma unroll
        for (int u = 0; u < 2; ++u) { const int m = m0 + u * NGW; if (m < M) {
#pragma unroll
            for (int j = 0; j < 4; ++j) s[u] += (v[u][j].x * v[u][j].x + v[u][j].y * v[u][j].y) + (v[u][j].z * v[u][j].z + v[u][j].w * v[u][j].w);
            const float rstd = __builtin_amdgcn_rsqf(wave_sum(s[u]) * (1.f / D) + EPS);
            const float* mb = mod + (size_t)bid_of(m) * 3072;
#pragma unroll
            for (int j = 0; j < 4; ++j) { const int col = 4 * (lane + 64 * j);
                const f32x4 g4 = *(const f32x4*)(ng + col), sh = *(const f32x4*)(mb + col), sc = *(const f32x4*)(mb + 1024 + col);
                const f32x4 hh = v[u][j] * rstd * g4 * (sc + 1.f) + sh;
                u32x2 o; o.x = pk2(hh.x, hh.y); o.y = pk2(hh.z, hh.w);
                *(u32x2*)(H + (size_t)m * D + col) = o; } } }
    }
}

struct MlaTok { u32x2 cq; unsigned ckv, kra, krb, qa, qb; u32x4 q8, k8, v8, bz, cx0, cx1, cx2; };
__device__ __forceinline__ void mla_prep_phase(const Params& p, int vcu, int G) {
    const int tid = opaque_tid(), lane = tid & 63, wave = tid >> 6, h = lane >> 3, j = lane & 7;
    const int gw = vcu * 8 + wave, NGW = G * 8;
    const bf16_t* P0 = (const bf16_t*)(p.ws + WS_P);
    bf16_t* QU = (bf16_t*)((unsigned char*)p.out + OUT_Q);
    bf16_t* KV = (bf16_t*)((unsigned char*)p.out + OUT_KV);
    bf16_t* Vb = (bf16_t*)(p.ws + WS_V);
    bf16_t* YC = (bf16_t*)(p.ws + WS_H);
    float qg[12], kg[12];
#pragma unroll
    for (int i = 0; i < 8; ++i) { qg[i] = p.q_gain[8 * j + i]; kg[i] = p.k_gain[8 * j + i]; }
#pragma unroll
    for (int i = 0; i < 2; ++i) { qg[8 + i] = p.q_gain[64 + 2 * j + i]; qg[10 + i] = p.q_gain[80 + 2 * j + i]; kg[8 + i] = p.k_gain[64 + 2 * j + i]; kg[10 + i] = p.k_gain[80 + 2 * j + i]; }
    float inv[2];
#pragma unroll
    for (int i = 0; i < 2; ++i) inv[i] = exp2f(-(float)(2 * j + i) * (13.287712379549449f / 16.f));
    float cw[3][8];
#pragma unroll
    for (int t = 0; t < 3; ++t)
#pragma unroll
        for (int i = 0; i < 8; ++i) cw[t][i] = p.a_conv[t * 512 + 8 * lane + i];
#define MLA_LOAD(T, m) do { const int m_ = (m); const int pos_ = m_ < MP ? (m_ & 4095) : ((m_ - MP) & 2047); const int Sb_ = m_ < MP ? 4096 : 2048; \
        const bf16_t* pr_ = P0 + (size_t)m_ * LDP0; \
        T.cq = *(const u32x2*)(pr_ + 2048 + 4 * lane); T.ckv = *(const unsigned*)(pr_ + 2304 + 2 * lane); \
        T.kra = *(const unsigned*)(pr_ + 2432 + 2 * j); T.krb = *(const unsigned*)(pr_ + 2448 + 2 * j); \
        const bf16_t* qr_ = QU + (size_t)m_ * 768 + h * 96; \
        T.q8 = *(const u32x4*)(qr_ + 8 * j); T.qa = *(const unsigned*)(qr_ + 64 + 2 * j); T.qb = *(const unsigned*)(qr_ + 80 + 2 * j); \
        const bf16_t* kv_ = KV + (size_t)m_ * 1024 + h * 128; \
        T.k8 = *(const u32x4*)(kv_ + 8 * j); T.v8 = *(const u32x4*)(kv_ + 64 + 8 * j); \
        T.bz = *(const u32x4*)(pr_ + 512 + 8 * lane); T.cx1 = *(const u32x4*)(pr_ + 8 * lane); \
        T.cx0 = *(const u32x4*)(pr_ - (pos_ > 0 ? LDP0 : 0) + 8 * lane); T.cx2 = *(const u32x4*)(pr_ + (pos_ < Sb_ - 1 ? LDP0 : 0) + 8 * lane); } while (0)
#define MLA_COMPUTE(T, m) do { const int m_ = (m); const int pos = m_ < MP ? (m_ & 4095) : ((m_ - MP) & 2047); const int Sb = m_ < MP ? 4096 : 2048; \
        bf16_t* qrow = QU + (size_t)m_ * 768 + h * 96; bf16_t* kvrow = KV + (size_t)m_ * 1024; \
        const float sq = bflo(T.cq.x) * bflo(T.cq.x) + bfhi(T.cq.x) * bfhi(T.cq.x) + bflo(T.cq.y) * bflo(T.cq.y) + bfhi(T.cq.y) * bfhi(T.cq.y); \
        const float rstd_q = __builtin_amdgcn_rsqf(wave_sum(sq) * (1.f / 256.f) + EPS); \
        const float skv = bflo(T.ckv) * bflo(T.ckv) + bfhi(T.ckv) * bfhi(T.ckv); \
        const float rstd_kv = __builtin_amdgcn_rsqf(wave_sum(skv) * (1.f / 128.f) + EPS); \
        float cs[2], sn[2]; \
        _Pragma("unroll") for (int i = 0; i < 2; ++i) { const float angf = (float)pos * inv[i]; const double a_ = (double)angf; const double n_ = rint(a_ * 0.15915494309189535); \
            const float rf = (float)(a_ - n_ * 6.283185307179586); cs[i] = __cosf(rf); sn[i] = __sinf(rf); } \
        { float x[12]; \
          x[0] = bflo(T.q8.x); x[1] = bfhi(T.q8.x); x[2] = bflo(T.q8.y); x[3] = bfhi(T.q8.y); x[4] = bflo(T.q8.z); x[5] = bfhi(T.q8.z); x[6] = bflo(T.q8.w); x[7] = bfhi(T.q8.w); \
          x[8] = bflo(T.qa); x[9] = bfhi(T.qa); x[10] = bflo(T.qb); x[11] = bfhi(T.qb); \
          float ss = 0.f; \
          _Pragma("unroll") for (int i = 0; i < 12; ++i) { x[i] *= rstd_q; ss += x[i] * x[i]; } \
          const float r = __builtin_amdgcn_rsqf(sum8(ss) * (1.f / 96.f) + EPS) * QSCALE_B; \
          _Pragma("unroll") for (int i = 0; i < 12; ++i) x[i] *= r * qg[i]; \
          const float o8 = x[8] * cs[0] - x[10] * sn[0], o10 = x[8] * sn[0] + x[10] * cs[0]; \
          const float o9 = x[9] * cs[1] - x[11] * sn[1], o11 = x[9] * sn[1] + x[11] * cs[1]; \
          u32x4 w; w.x = pk2(x[0], x[1]); w.y = pk2(x[2], x[3]); w.z = pk2(x[4], x[5]); w.w = pk2(x[6], x[7]); \
          *(u32x4*)(qrow + 8 * j) = w; *(unsigned*)(qrow + 64 + 2 * j) = pk2(o8, o9); *(unsigned*)(qrow + 80 + 2 * j) = pk2(o10, o11); } \
        { float x[12]; \
          x[0] = bflo(T.k8.x); x[1] = bfhi(T.k8.x); x[2] = bflo(T.k8.y); x[3] = bfhi(T.k8.y); x[4] = bflo(T.k8.z); x[5] = bfhi(T.k8.z); x[6] = bflo(T.k8.w); x[7] = bfhi(T.k8.w); \
          _Pragma("unroll") for (int i = 0; i < 8; ++i) x[i] *= rstd_kv; \
          x[8] = bflo(T.kra); x[9] = bfhi(T.kra); x[10] = bflo(T.krb); x[11] = bfhi(T.krb); \
          float ss = 0.f; \
          _Pragma("unroll") for (int i = 0; i < 12; ++i) ss += x[i] * x[i]; \
          const float r = __builtin_amdgcn_rsqf(sum8(ss) * (1.f / 96.f) + EPS); \
          _Pragma("unroll") for (int i = 0; i < 12; ++i) x[i] *= r * kg[i]; \
          const float o8 = x[8] * cs[0] - x[10] * sn[0], o10 = x[8] * sn[0] + x[10] * cs[0]; \
          const float o9 = x[9] * cs[1] - x[11] * sn[1], o11 = x[9] * sn[1] + x[11] * cs[1]; \
          bf16_t* krow = kvrow + h * 96; \
          u32x4 w; w.x = pk2(x[0], x[1]); w.y = pk2(x[2], x[3]); w.z = pk2(x[4], x[5]); w.w = pk2(x[6], x[7]); \
          *(u32x4*)(krow + 8 * j) = w; *(unsigned*)(krow + 64 + 2 * j) = pk2(o8, o9); *(unsigned*)(krow + 80 + 2 * j) = pk2(o10, o11); } \
        { u32x4 w; w.x = pk2(bflo(T.v8.x) * rstd_kv, bfhi(T.v8.x) * rstd_kv); w.y = pk2(bflo(T.v8.y) * rstd_kv, bfhi(T.v8.y) * rstd_kv); \
          w.z = pk2(bflo(T.v8.z) * rstd_kv, bfhi(T.v8.z) * rstd_kv); w.w = pk2(bflo(T.v8.w) * rstd_kv, bfhi(T.v8.w) * rstd_kv); \
          *(u32x4*)(Vb + (size_t)m_ * 512 + h * 64 + 8 * j) = w; } \
        { const float fp = pos > 0 ? 1.f : 0.f, fn = pos < Sb - 1 ? 1.f : 0.f; float y[8]; \
          _Pragma("unroll") for (int i = 0; i < 4; ++i) { \
              const float cvl = cw[0][2 * i] * (fp * bflo(T.cx0[i])) + cw[1][2 * i] * bflo(T.cx1[i]) + cw[2][2 * i] * (fn * bflo(T.cx2[i])); \
              const float cvh = cw[0][2 * i + 1] * (fp * bfhi(T.cx0[i])) + cw[1][2 * i + 1] * bfhi(T.cx1[i]) + cw[2][2 * i + 1] * (fn * bfhi(T.cx2[i])); \
              y[2 * i] = bflo(T.bz[i]) * cvl; y[2 * i + 1] = bfhi(T.bz[i]) * cvh; } \
          u32x4 w; w.x = pk2(y[0], y[1]); w.y = pk2(y[2], y[3]); w.z = pk2(y[4], y[5]); w.w = pk2(y[6], y[7]); \
          *(u32x4*)((bf16_t*)P0 + (size_t)m_ * LDP0 + 512 + 8 * lane) = w; } } while (0)
    MlaTok A, B;
    int m = gw;
    if (m < M) MLA_LOAD(A, m);
    for (; m < M; m += 2 * NGW) {
        const int m2 = m + NGW, m3 = m + 2 * NGW;
        if (m2 < M) { MLA_LOAD(B, m2); asm volatile("s_waitcnt vmcnt(13)" ::: "memory"); } else { VM_WAIT(); }
        MLA_COMPUTE(A, m);
        if (m2 < M) {
            if (m3 < M) { MLA_LOAD(A, m3); asm volatile("s_waitcnt vmcnt(13)" ::: "memory"); } else { VM_WAIT(); }
            MLA_COMPUTE(B, m2);
        }
    }
#undef MLA_LOAD
#undef MLA_COMPUTE
}

__device__ __forceinline__ void attn_dense_phase(const Params& p, LAS unsigned char* lds, int vcu) {
    const int tid = opaque_tid(), lane = tid & 63, wid = tid >> 6, r32 = lane & 31, hi = lane >> 5, j16 = lane & 15, g16 = lane >> 4;
    constexpr int KROW = 208, VROW = 192, KBUF = 128 * KROW, VBUF = 128 * VROW;
    const bf16_t* Qg = (const bf16_t*)((const unsigned char*)p.out + OUT_Q);
    const bf16_t* Kg = (const bf16_t*)((const unsigned char*)p.out + OUT_KV);
    const bf16_t* Vg = (const bf16_t*)(p.ws + WS_V);
    const bf16_t* P0 = (const bf16_t*)(p.ws + WS_P);
    bf16_t* YC = (bf16_t*)(p.ws + WS_H);
    LAS unsigned char* Kl = lds; LAS unsigned char* Vl = lds + 2 * KBUF;
    int krow[3], kcc[3], vrow[2], vcc[2];
#pragma unroll
    for (int i = 0; i < 3; ++i) { const int c = tid + 512 * i; krow[i] = c / 12; kcc[i] = c % 12; }
#pragma unroll
    for (int i = 0; i < 2; ++i) { const int c = tid + 512 * i; vrow[i] = c >> 3; vcc[i] = c & 7; }
    const unsigned vrd = (unsigned)(uintptr_t)Vl + (unsigned)((4 * hi + (j16 >> 2)) * VROW + (16 * (g16 & 1) + 4 * (j16 & 3)) * 2);
    for (int it = 0; it < 12; ++it) {
        int S, mb, h, qb;
        if (it < 4) { const int u = vcu + 256 * it; const int bh = u >> 4; qb = u & 15; h = bh & 7; S = 4096; mb = (bh >> 3) * 4096; }
        else { const int u = vcu + 256 * (it - 4); const int bh = u >> 3; qb = u & 7; h = bh & 7; S = 2048; mb = MP + (bh >> 3) * 2048; }
        const int mq = mb + qb * 256 + wid * 32 + r32;
        bf16x8 qf[6];
#pragma unroll
        for (int k0 = 0; k0 < 6; ++k0) qf[k0] = *(const bf16x8*)(Qg + (size_t)mq * 768 + h * 96 + k0 * 16 + hi * 8);
        f32x16 o0 = {}, o1 = {};
        float m_run = -1e30f, l_run = 0.f;
        const int NT = S >> 7;
        u32x4 kreg[3], vreg[2];
#define A_LOAD(t) do { const size_t mk = (size_t)(mb + (t) * 128); \
        _Pragma("unroll") for (int i = 0; i < 3; ++i) kreg[i] = *(const u32x4*)(Kg + (mk + krow[i]) * 1024 + h * 96 + kcc[i] * 8); \
        _Pragma("unroll") for (int i = 0; i < 2; ++i) vreg[i] = *(const u32x4*)(Vg + (mk + vrow[i]) * 512 + h * 64 + vcc[i] * 8); } while (0)
#define A_WRITE(b) do { \
        _Pragma("unroll") for (int i = 0; i < 3; ++i) *(LAS u32x4*)(Kl + (b) * KBUF + krow[i] * KROW + kcc[i] * 16) = kreg[i]; \
        _Pragma("unroll") for (int i = 0; i < 2; ++i) *(LAS u32x4*)(Vl + (b) * VBUF + vrow[i] * VROW + vcc[i] * 16) = vreg[i]; } while (0)
        A_LOAD(0); A_WRITE(0); __syncthreads();
        for (int t = 0; t < NT; ++t) {
            const int b = t & 1;
            if (t + 1 < NT) A_LOAD(t + 1);
            const LAS unsigned char* Kb = Kl + b * KBUF;
            const unsigned vb = vrd + (unsigned)(b * VBUF);
#pragma unroll
            for (int kh = 0; kh < 2; ++kh) {
                f32x16 s0 = {}, s1 = {};
#pragma unroll
                for (int k0 = 0; k0 < 6; ++k0) {
                    const bf16x8 a0 = *(const LAS bf16x8*)(Kb + (kh * 64 + r32) * KROW + (k0 * 16 + hi * 8) * 2);
                    const bf16x8 a1 = *(const LAS bf16x8*)(Kb + (kh * 64 + 32 + r32) * KROW + (k0 * 16 + hi * 8) * 2);
                    s0 = __builtin_amdgcn_mfma_f32_32x32x16_bf16(a0, qf[k0], s0, 0, 0, 0);
                    s1 = __builtin_amdgcn_mfma_f32_32x32x16_bf16(a1, qf[k0], s1, 0, 0, 0);
                }
                s16x4 tv[4][4];
                { const unsigned vbh = vb + (unsigned)(kh * 64 * VROW);
                  tv[0][0] = tr_read<0 * 16 * VROW>(vbh); tv[0][1] = tr_read<0 * 16 * VROW + 8 * VROW>(vbh); tv[0][2] = tr_read<0 * 16 * VROW + 64>(vbh); tv[0][3] = tr_read<0 * 16 * VROW + 64 + 8 * VROW>(vbh);
                  tv[1][0] = tr_read<1 * 16 * VROW>(vbh); tv[1][1] = tr_read<1 * 16 * VROW + 8 * VROW>(vbh); tv[1][2] = tr_read<1 * 16 * VROW + 64>(vbh); tv[1][3] = tr_read<1 * 16 * VROW + 64 + 8 * VROW>(vbh);
                  tv[2][0] = tr_read<2 * 16 * VROW>(vbh); tv[2][1] = tr_read<2 * 16 * VROW + 8 * VROW>(vbh); tv[2][2] = tr_read<2 * 16 * VROW + 64>(vbh); tv[2][3] = tr_read<2 * 16 * VROW + 64 + 8 * VROW>(vbh);
                  tv[3][0] = tr_read<3 * 16 * VROW>(vbh); tv[3][1] = tr_read<3 * 16 * VROW + 8 * VROW>(vbh); tv[3][2] = tr_read<3 * 16 * VROW + 64>(vbh); tv[3][3] = tr_read<3 * 16 * VROW + 64 + 8 * VROW>(vbh); }
                float mx = s0[0];
#pragma unroll
                for (int r = 1; r < 16; ++r) mx = fmaxf(mx, s0[r]);
#pragma unroll
                for (int r = 0; r < 16; ++r) mx = fmaxf(mx, s1[r]);
                mx = swap_max(mx);
                if (__any(mx > m_run)) {
                    const float mn = fmaxf(m_run, mx), alpha = fexp2(m_run - mn); m_run = mn;
                    l_run *= alpha; o0 *= alpha; o1 *= alpha;
                }
                const float mn = m_run;
                float ls = 0.f;
#pragma unroll
                for (int r = 0; r < 16; ++r) { s0[r] = fexp2(s0[r] - mn); ls += s0[r]; }
#pragma unroll
                for (int r = 0; r < 16; ++r) { s1[r] = fexp2(s1[r] - mn); ls += s1[r]; }
                l_run += ls;
                bf16x8 pf[4];
                { u32x4 w;
                  w.x = pk2(s0[0], s0[1]); w.y = pk2(s0[2], s0[3]); w.z = pk2(s0[4], s0[5]); w.w = pk2(s0[6], s0[7]); pf[0] = *(bf16x8*)&w;
                  w.x = pk2(s0[8], s0[9]); w.y = pk2(s0[10], s0[11]); w.z = pk2(s0[12], s0[13]); w.w = pk2(s0[14], s0[15]); pf[1] = *(bf16x8*)&w;
                  w.x = pk2(s1[0], s1[1]); w.y = pk2(s1[2], s1[3]); w.z = pk2(s1[4], s1[5]); w.w = pk2(s1[6], s1[7]); pf[2] = *(bf16x8*)&w;
                  w.x = pk2(s1[8], s1[9]); w.y = pk2(s1[10], s1[11]); w.z = pk2(s1[12], s1[13]); w.w = pk2(s1[14], s1[15]); pf[3] = *(bf16x8*)&w; }
                LDS_WAIT(); SBAR();
#pragma unroll
                for (int J = 0; J < 4; ++J) {
                    o0 = __builtin_amdgcn_mfma_f32_32x32x16_bf16(PK8(tv[J][0], tv[J][1]), pf[J], o0, 0, 0, 0);
                    o1 = __builtin_amdgcn_mfma_f32_32x32x16_bf16(PK8(tv[J][2], tv[J][3]), pf[J], o1, 0, 0, 0);
                }
            }
            if (t + 1 < NT) A_WRITE(b ^ 1);
            __syncthreads();
        }
#undef A_LOAD
#undef A_WRITE
        const float linv = frcp(swap_sum(l_run));
        const bf16_t* zr = P0 + (size_t)mq * LDP0 + 2464 + h * 64;
        bf16_t* yr = (bf16_t*)P0 + (size_t)mq * LDP0 + 2464 + h * 64;
#pragma unroll
        for (int db = 0; db < 2; ++db)
#pragma unroll
            for (int rg = 0; rg < 4; ++rg) {
                const int d0 = db * 32 + 8 * rg + 4 * hi;
                const u32x2 z = *(const u32x2*)(zr + d0);
                const f32x16& o = db == 0 ? o0 : o1;
                const float y0 = o[4 * rg + 0] * linv * silu(bflo(z.x)), y1 = o[4 * rg + 1] * linv * silu(bfhi(z.x));
                const float y2 = o[4 * rg + 2] * linv * silu(bflo(z.y)), y3 = o[4 * rg + 3] * linv * silu(bfhi(z.y));
                u32x2 w; w.x = pk2(y0, y1); w.y = pk2(y2, y3);
                *(u32x2*)(yr + d0) = w;
            }
    }
}

template <bool NM>
__device__ __forceinline__ void attn_dense_phase3(const Params& p, LAS unsigned char* lds, int vcu) {
    const int tid = opaque_tid(), lane = tid & 63, wid = __builtin_amdgcn_readfirstlane(tid >> 6), r32 = lane & 31, hi = lane >> 5, j16 = lane & 15, g16 = lane >> 4;
    constexpr int KROW = 208, KBUF = 64 * KROW, VBUF = 64 * 128, TBUF = KBUF + VBUF;
    const bf16_t* Qg = (const bf16_t*)((const unsigned char*)p.out + OUT_Q);
    const bf16_t* Kg = (const bf16_t*)((const unsigned char*)p.out + OUT_KV);
    const bf16_t* Vg = (const bf16_t*)(p.ws + WS_V);
    const bf16_t* P0 = (const bf16_t*)(p.ws + WS_P);
    bf16_t* YC = (bf16_t*)(p.ws + WS_H);
    const bool lowhalf = wid < 4;
    int goff[3], gstep[3], loff[3];
    { const int c0 = tid; goff[0] = (c0 / 12) * 1024 + (c0 % 12) * 8; gstep[0] = 64 * 1024; loff[0] = (c0 / 12) * KROW + (c0 % 12) * 16; }
    if (lowhalf) { const int c1 = 512 + tid; goff[1] = (c1 / 12) * 1024 + (c1 % 12) * 8; gstep[1] = 64 * 1024; loff[1] = (c1 / 12) * KROW + (c1 % 12) * 16;
                   const int v2 = 256 + tid; const int row = v2 >> 3, c = v2 & 7; goff[2] = row * 512 + c * 8; gstep[2] = 64 * 512; loff[2] = KBUF + row * 128 + ((c ^ (((row >> 1) & 1) << 2)) << 4); }
    else { const int v1 = tid - 256; const int row = v1 >> 3, c = v1 & 7; goff[1] = row * 512 + c * 8; gstep[1] = 64 * 512; loff[1] = KBUF + row * 128 + ((c ^ (((row >> 1) & 1) << 2)) << 4);
           goff[2] = 0; gstep[2] = 0; loff[2] = 0; }
    if (wid >= 4) __builtin_amdgcn_s_setprio(1);
    const int fsw = (j16 >> 3) & 1;
    const unsigned vrowb = (unsigned)(uintptr_t)lds + (unsigned)(KBUF + (4 * hi + (j16 >> 2)) * 128 + 32 * (g16 & 1) + 8 * (j16 & 3));
    const unsigned vb0 = vrowb + (unsigned)(fsw * 64), vb1 = vrowb + (unsigned)((1 - fsw) * 64);
    const LAS unsigned char* kfb = lds + r32 * KROW + hi * 16;
#pragma unroll 1
    for (int it = 0; it < 12; ++it) {
        int S, mb, h, qb;
        if (it < 4) { const int u = vcu + 256 * it; const int bh = u >> 4; qb = u & 15; h = bh & 7; S = 4096; mb = (bh >> 3) * 4096; }
        else { const int u = vcu + 256 * (it - 4); const int bh = u >> 3; qb = u & 7; h = bh & 7; S = 2048; mb = MP + (bh >> 3) * 2048; }
        const int mq = mb + qb * 256 + wid * 32 + r32;
        bf16x8 qf[6];
#pragma unroll
        for (int k0 = 0; k0 < 6; ++k0) qf[k0] = *(const bf16x8*)(Qg + (size_t)mq * 768 + h * 96 + k0 * 16 + hi * 8);
        f32x16 o0 = {}, o1 = {};
        float m_run = -1e30f, l_run = 0.f;
        const int NT = S >> 6;
        const bf16_t* gp0 = Kg + (size_t)mb * 1024 + h * 96 + goff[0];
        const bf16_t* gp1 = lowhalf ? Kg + (size_t)mb * 1024 + h * 96 + goff[1] : Vg + (size_t)mb * 512 + h * 64 + goff[1];
        const bf16_t* gp2 = Vg + (size_t)mb * 512 + h * 64 + goff[2];
        u32x4 sra[3];
#define B_LOAD(R, t) do { R[0] = *(const u32x4*)(gp0 + (size_t)(t) * gstep[0]); R[1] = *(const u32x4*)(gp1 + (size_t)(t) * gstep[1]); if (lowhalf) R[2] = *(const u32x4*)(gp2 + (size_t)(t) * gstep[2]); } while (0)
#define B_WRITE(R, bo) do { *(LAS u32x4*)(lds + (bo) + loff[0]) = R[0]; *(LAS u32x4*)(lds + (bo) + loff[1]) = R[1]; if (lowhalf) *(LAS u32x4*)(lds + (bo) + loff[2]) = R[2]; } while (0)
#define B_QK(SA, SB, bo) do { SA = (f32x16){}; SB = (f32x16){}; bf16x8 kfa[6], kfc[6]; \
        _Pragma("unroll") for (int k0 = 0; k0 < 6; ++k0) { kfa[k0] = *(const LAS bf16x8*)(kfb + (bo) + k0 * 32); kfc[k0] = *(const LAS bf16x8*)(kfb + (bo) + 32 * KROW + k0 * 32); } \
        _Pragma("unroll") for (int k0 = 0; k0 < 6; ++k0) { \
            SA = __builtin_amdgcn_mfma_f32_32x32x16_bf16(kfa[k0], qf[k0], SA, 0, 0, 0); SB = __builtin_amdgcn_mfma_f32_32x32x16_bf16(kfc[k0], qf[k0], SB, 0, 0, 0); } } while (0)
        __syncthreads();
        B_LOAD(sra, 0); B_WRITE(sra, 0); B_LOAD(sra, 1); B_WRITE(sra, TBUF); __syncthreads();
        f32x16 sa0, sa1, sb0, sb1;
        B_QK(sa0, sa1, 0);
        int bc = 0, bn = TBUF, bw = 2 * TBUF;
#define B_STAGE(C0, C1, N0, N1, t) do { \
        if ((t) + 2 < NT) B_LOAD(sra, (t) + 2); \
        s16x4 tv[4][4]; \
        { const unsigned a0 = vb0 + (unsigned)bc, a1 = vb1 + (unsigned)bc; \
          tv[0][0] = tr_read<0>(a0); tv[0][1] = tr_read<1024>(a0); tv[0][2] = tr_read<0>(a1); tv[0][3] = tr_read<1024>(a1); \
          tv[1][0] = tr_read<2048>(a0); tv[1][1] = tr_read<3072>(a0); tv[1][2] = tr_read<2048>(a1); tv[1][3] = tr_read<3072>(a1); \
          tv[2][0] = tr_read<4096>(a0); tv[2][1] = tr_read<5120>(a0); tv[2][2] = tr_read<4096>(a1); tv[2][3] = tr_read<5120>(a1); \
          tv[3][0] = tr_read<6144>(a0); tv[3][1] = tr_read<7168>(a0); tv[3][2] = tr_read<6144>(a1); tv[3][3] = tr_read<7168>(a1); } \
        bf16x8 kfa[6], kfc[6]; \
        _Pragma("unroll") for (int k0 = 0; k0 < 6; ++k0) { kfa[k0] = *(const LAS bf16x8*)(kfb + bn + k0 * 32); kfc[k0] = *(const LAS bf16x8*)(kfb + bn + 32 * KROW + k0 * 32); } \
        if (!NM) { \
        float mx = C0[0]; \
        _Pragma("unroll") for (int r = 1; r < 16; ++r) mx = fmaxf(mx, C0[r]); \
        _Pragma("unroll") for (int r = 0; r < 16; ++r) mx = fmaxf(mx, C1[r]); \
        mx = swap_max(mx); \
        if (__any(mx > m_run)) { const float mn_ = fmaxf(m_run, mx), alpha = fexp2(m_run - mn_); m_run = mn_; l_run *= alpha; o0 *= alpha; o1 *= alpha; } } \
        N0 = (f32x16){}; N1 = (f32x16){}; \
        _Pragma("unroll") for (int k0 = 0; k0 < 6; ++k0) { \
            N0 = __builtin_amdgcn_mfma_f32_32x32x16_bf16(kfa[k0], qf[k0], N0, 0, 0, 0); N1 = __builtin_amdgcn_mfma_f32_32x32x16_bf16(kfc[k0], qf[k0], N1, 0, 0, 0); } \
        const float mn = NM ? 0.f : m_run; float ls = 0.f; \
        _Pragma("unroll") for (int r = 0; r < 16; ++r) { C0[r] = NM ? fexp2(C0[r]) : fexp2(C0[r] - mn); ls += C0[r]; } \
        _Pragma("unroll") for (int r = 0; r < 16; ++r) { C1[r] = NM ? fexp2(C1[r]) : fexp2(C1[r] - mn); ls += C1[r]; } \
        l_run += ls; \
        bf16x8 pf[4]; \
        { u32x4 w; \
          w.x = pk2(C0[0], C0[1]); w.y = pk2(C0[2], C0[3]); w.z = pk2(C0[4], C0[5]); w.w = pk2(C0[6], C0[7]); pf[0] = *(bf16x8*)&w; \
          w.x = pk2(C0[8], C0[9]); w.y = pk2(C0[10], C0[11]); w.z = pk2(C0[12], C0[13]); w.w = pk2(C0[14], C0[15]); pf[1] = *(bf16x8*)&w; \
          w.x = pk2(C1[0], C1[1]); w.y = pk2(C1[2], C1[3]); w.z = pk2(C1[4], C1[5]); w.w = pk2(C1[6], C1[7]); pf[2] = *(bf16x8*)&w; \
          w.x = pk2(C1[8], C1[9]); w.y = pk2(C1[10], C1[11]); w.z = pk2(C1[12], C1[13]); w.w = pk2(C1[14], C1[15]); pf[3] = *(bf16x8*)&w; } \
        _Pragma("unroll") for (int g_ = 0; g_ < 12; ++g_) { __builtin_amdgcn_sched_group_barrier(0x008, 1, 0); __builtin_amdgcn_sched_group_barrier(0x002, 9, 0); } \
        LDS_WAIT(); SBAR(); \
        _Pragma("unroll") for (int J = 0; J < 4; ++J) { \
            o0 = __builtin_amdgcn_mfma_f32_32x32x16_bf16(PK8(tv[J][0], tv[J][1]), pf[J], o0, 0, 0, 0); \
            o1 = __builtin_amdgcn_mfma_f32_32x32x16_bf16(PK8(tv[J][2], tv[J][3]), pf[J], o1, 0, 0, 0); } \
        if ((t) + 2 < NT) B_WRITE(sra, bw); \
        __syncthreads(); \
        { const int tmp = bc; bc = bn; bn = bw; bw = tmp; } } while (0)
#pragma unroll 1
        for (int t = 0; t < NT; t += 2) {
            B_STAGE(sa0, sa1, sb0, sb1, t);
            B_STAGE(sb0, sb1, sa0, sa1, t + 1);
        }
#undef B_STAGE
#undef B_QK
#undef B_LOAD
#undef B_WRITE
        const float linv = frcp(swap_sum(l_run));
        const bf16_t* zr = P0 + (size_t)mq * LDP0 + 2464 + h * 64;
        bf16_t* yr = (bf16_t*)P0 + (size_t)mq * LDP0 + 2464 + h * 64;
#pragma unroll
        for (int db = 0; db < 2; ++db)
#pragma unroll
            for (int rg = 0; rg < 4; ++rg) {
                const int d0 = db * 32 + 8 * rg + 4 * hi;
                const u32x2 z = *(const u32x2*)(zr + d0);
                const f32x16& o = db == 0 ? o0 : o1;
                const float y0 = o[4 * rg + 0] * linv * silu(bflo(z.x)), y1 = o[4 * rg + 1] * linv * silu(bfhi(z.x));
                const float y2 = o[4 * rg + 2] * linv * silu(bflo(z.y)), y3 = o[4 * rg + 3] * linv * silu(bfhi(z.y));
                u32x2 w; w.x = pk2(y0, y1); w.y = pk2(y2, y3);
                *(u32x2*)(yr + d0) = w;
            }
    }
    __builtin_amdgcn_s_setprio(0);
}

template <bool NM>
__device__ __forceinline__ void attn_dense_phase7(const Params& p, LAS unsigned char* lds, int vcu) {
    const int tid = opaque_tid(), lane = tid & 63, wid = __builtin_amdgcn_readfirstlane(tid >> 6), r32 = lane & 31, hi = lane >> 5, j16 = lane & 15, g16 = lane >> 4;
    constexpr int KROW = 208, KBUF = 64 * KROW, VBUF = 64 * 128, TBUF = KBUF + VBUF;
    const bf16_t* Qg = (const bf16_t*)((const unsigned char*)p.out + OUT_Q);
    const bf16_t* Kg = (const bf16_t*)((const unsigned char*)p.out + OUT_KV);
    const bf16_t* Vg = (const bf16_t*)(p.ws + WS_V);
    const bf16_t* P0 = (const bf16_t*)(p.ws + WS_P);
    bf16_t* YC = (bf16_t*)(p.ws + WS_H);
    const bool lowhalf = wid < 4;
    int goff0, goff1, goff2 = 0, loff0, loff1, loff2 = 0;
    { const int c0 = tid; goff0 = (c0 / 12) * 1024 + (c0 % 12) * 8; loff0 = (c0 / 12) * KROW + (c0 % 12) * 16; }
    if (lowhalf) { const int c1 = 512 + tid; goff1 = (c1 / 12) * 1024 + (c1 % 12) * 8; loff1 = (c1 / 12) * KROW + (c1 % 12) * 16;
                   const int v2 = 256 + tid; const int row = v2 >> 3, c = v2 & 7; goff2 = row * 512 + c * 8; loff2 = KBUF + row * 128 + ((c ^ (((row >> 1) & 1) << 2)) << 4); }
    else { const int v1 = tid - 256; const int row = v1 >> 3, c = v1 & 7; goff1 = row * 512 + c * 8; loff1 = KBUF + row * 128 + ((c ^ (((row >> 1) & 1) << 2)) << 4); }
    const int fsw = (j16 >> 3) & 1;
    const unsigned vrowb = (unsigned)(uintptr_t)lds + (unsigned)(KBUF + (4 * hi + (j16 >> 2)) * 128 + 32 * (g16 & 1) + 8 * (j16 & 3));
    const unsigned vb0 = vrowb + (unsigned)(fsw * 64), vb1 = vrowb + (unsigned)((1 - fsw) * 64);
    const LAS unsigned char* kfb = lds + r32 * KROW + hi * 16;
#pragma unroll 1
    for (int it = 0; it < 12; ++it) {
        int S, mb, h, qb;
        if (it < 4) { const int u = vcu + 256 * it; const int bh = u >> 4; qb = u & 15; h = bh & 7; S = 4096; mb = (bh >> 3) * 4096; }
        else { const int u = vcu + 256 * (it - 4); const int bh = u >> 3; qb = u & 7; h = bh & 7; S = 2048; mb = MP + (bh >> 3) * 2048; }
        const int mq = mb + qb * 256 + wid * 32 + r32;
        bf16x8 qf[6];
#pragma unroll
        for (int k0 = 0; k0 < 6; ++k0) qf[k0] = *(const bf16x8*)(Qg + (size_t)mq * 768 + h * 96 + k0 * 16 + hi * 8);
        f32x16 o0 = {}, o1 = {};
        float m_run = -1e30f, l_run = 0.f;
        const int NT = S >> 6;
        const bf16_t* gp0 = Kg + (size_t)mb * 1024 + h * 96 + goff0;
        const int stride1 = lowhalf ? 64 * 1024 : 64 * 512;
        const bf16_t* gp1 = lowhalf ? Kg + (size_t)mb * 1024 + h * 96 + goff1 : Vg + (size_t)mb * 512 + h * 64 + goff1;
        const bf16_t* gp2 = Vg + (size_t)mb * 512 + h * 64 + goff2;
        u32x4 sra[3];
#define B_LOAD(R, t) do { R[0] = *(const u32x4*)gp0; R[1] = *(const u32x4*)gp1; if (lowhalf) R[2] = *(const u32x4*)gp2; gp0 += 64 * 1024; gp1 += stride1; gp2 += 64 * 512; } while (0)
#define B_WRITE(R, bo) do { *(LAS u32x4*)(lds + (bo) + loff0) = R[0]; *(LAS u32x4*)(lds + (bo) + loff1) = R[1]; if (lowhalf) *(LAS u32x4*)(lds + (bo) + loff2) = R[2]; } while (0)
#define B_QK(SA, SB, bo) do { SA = (f32x16){}; SB = (f32x16){}; bf16x8 kfa[6], kfc[6]; \
        _Pragma("unroll") for (int k0 = 0; k0 < 6; ++k0) { kfa[k0] = *(const LAS bf16x8*)(kfb + (bo) + k0 * 32); kfc[k0] = *(const LAS bf16x8*)(kfb + (bo) + 32 * KROW + k0 * 32); } \
        _Pragma("unroll") for (int k0 = 0; k0 < 6; ++k0) { \
            SA = __builtin_amdgcn_mfma_f32_32x32x16_bf16(kfa[k0], qf[k0], SA, 0, 0, 0); SB = __builtin_amdgcn_mfma_f32_32x32x16_bf16(kfc[k0], qf[k0], SB, 0, 0, 0); } } while (0)
        __syncthreads();
        *(LAS u32x4*)(lds + 3 * TBUF + KBUF + tid * 16) = (u32x4){0u, 0u, 0u, 0u};
        B_LOAD(sra, 0); B_WRITE(sra, 0); B_LOAD(sra, 1); B_WRITE(sra, TBUF); B_LOAD(sra, 2); __syncthreads();
        f32x16 sa0, sa1, sb0, sb1;
        B_QK(sa0, sa1, 0);
        int bp = 3 * TBUF, bc = 0, bn = TBUF, bw = 2 * TBUF;
        bf16x8 pfa[4], pfb[4];
#pragma unroll
        for (int J = 0; J < 4; ++J) { pfa[J] = (bf16x8){0, 0, 0, 0, 0, 0, 0, 0}; pfb[J] = pfa[J]; }
#define G_STAGE(C0, C1, N0, N1, PP, PN, t) do { \
        if ((t) + 2 < NT) B_WRITE(sra, bw);        \
        if ((t) + 3 < NT) B_LOAD(sra, (t) + 3); \
        const unsigned va0 = vb0 + (unsigned)bp, va1 = vb1 + (unsigned)bp; \
        s16x4 tv[4][4]; \
        tv[0][0] = tr_read<0>(va0); tv[0][1] = tr_read<1024>(va0); tv[0][2] = tr_read<0>(va1); tv[0][3] = tr_read<1024>(va1); \
        tv[1][0] = tr_read<2048>(va0); tv[1][1] = tr_read<3072>(va0); tv[1][2] = tr_read<2048>(va1); tv[1][3] = tr_read<3072>(va1); \
          \
        N0 = (f32x16){}; N1 = (f32x16){}; \
        _Pragma("unroll") for (int k0 = 0; k0 < 6; ++k0) { \
            const bf16x8 ka_ = *(const LAS bf16x8*)(kfb + bn + k0 * 32), kc_ = *(const LAS bf16x8*)(kfb + bn + 32 * KROW + k0 * 32); \
            N0 = __builtin_amdgcn_mfma_f32_32x32x16_bf16(ka_, qf[k0], N0, 0, 0, 0); N1 = __builtin_amdgcn_mfma_f32_32x32x16_bf16(kc_, qf[k0], N1, 0, 0, 0); } \
        float ls = 0.f; \
        _Pragma("unroll") for (int r = 0; r < 16; ++r) { C0[r] = fexp2(C0[r]); ls += C0[r]; } \
        { u32x4 w; \
          w.x = pk2(C0[0], C0[1]); w.y = pk2(C0[2], C0[3]); w.z = pk2(C0[4], C0[5]); w.w = pk2(C0[6], C0[7]); PN[0] = *(bf16x8*)&w; \
          w.x = pk2(C0[8], C0[9]); w.y = pk2(C0[10], C0[11]); w.z = pk2(C0[12], C0[13]); w.w = pk2(C0[14], C0[15]); PN[1] = *(bf16x8*)&w; } \
        _Pragma("unroll") for (int g_ = 0; g_ < 12; ++g_) { __builtin_amdgcn_sched_group_barrier(0x008, 1, 0); __builtin_amdgcn_sched_group_barrier(0x002, 4, 0); } \
        LDS_WAIT(); SBAR(); \
          \
        tv[2][0] = tr_read<4096>(va0); tv[2][1] = tr_read<5120>(va0); tv[2][2] = tr_read<4096>(va1); tv[2][3] = tr_read<5120>(va1); \
        tv[3][0] = tr_read<6144>(va0); tv[3][1] = tr_read<7168>(va0); tv[3][2] = tr_read<6144>(va1); tv[3][3] = tr_read<7168>(va1); \
        _Pragma("unroll") for (int J = 0; J < 2; ++J) { \
            o0 = __builtin_amdgcn_mfma_f32_32x32x16_bf16(PK8(tv[J][0], tv[J][1]), PP[J], o0, 0, 0, 0); \
            o1 = __builtin_amdgcn_mfma_f32_32x32x16_bf16(PK8(tv[J][2], tv[J][3]), PP[J], o1, 0, 0, 0); } \
        _Pragma("unroll") for (int r = 0; r < 8; ++r) { C1[r] = fexp2(C1[r]); ls += C1[r]; } \
        { u32x4 w; w.x = pk2(C1[0], C1[1]); w.y = pk2(C1[2], C1[3]); w.z = pk2(C1[4], C1[5]); w.w = pk2(C1[6], C1[7]); PN[2] = *(bf16x8*)&w; } \
        _Pragma("unroll") for (int g_ = 0; g_ < 4; ++g_) { __builtin_amdgcn_sched_group_barrier(0x008, 1, 0); __builtin_amdgcn_sched_group_barrier(0x002, 5, 0); } \
        LDS_WAIT(); SBAR(); \
          \
        _Pragma("unroll") for (int J = 2; J < 4; ++J) { \
            o0 = __builtin_amdgcn_mfma_f32_32x32x16_bf16(PK8(tv[J][0], tv[J][1]), PP[J], o0, 0, 0, 0); \
            o1 = __builtin_amdgcn_mfma_f32_32x32x16_bf16(PK8(tv[J][2], tv[J][3]), PP[J], o1, 0, 0, 0); } \
        _Pragma("unroll") for (int r = 8; r < 16; ++r) { C1[r] = fexp2(C1[r]); ls += C1[r]; } \
        l_run += ls; \
        { u32x4 w; w.x = pk2(C1[8], C1[9]); w.y = pk2(C1[10], C1[11]); w.z = pk2(C1[12], C1[13]); w.w = pk2(C1[14], C1[15]); PN[3] = *(bf16x8*)&w; } \
        _Pragma("unroll") for (int g_ = 0; g_ < 4; ++g_) { __builtin_amdgcn_sched_group_barrier(0x008, 1, 0); __builtin_amdgcn_sched_group_barrier(0x002, 5, 0); } \
        SBAR(); \
        __syncthreads(); \
        { const int tmp = bp; bp = bc; bc = bn; bn = bw; bw = tmp; } } while (0)
#pragma unroll 1
        for (int t = 0; t < NT; t += 2) {
            G_STAGE(sa0, sa1, sb0, sb1, pfb, pfa, t);
            G_STAGE(sb0, sb1, sa0, sa1, pfa, pfb, t + 1);
        }
#undef G_STAGE
        {
            const unsigned a0 = vb0 + (unsigned)bp, a1 = vb1 + (unsigned)bp;
            s16x4 tv[4][4];
            tv[0][0] = tr_read<0>(a0); tv[0][1] = tr_read<1024>(a0); tv[0][2] = tr_read<0>(a1); tv[0][3] = tr_read<1024>(a1);
            tv[1][0] = tr_read<2048>(a0); tv[1][1] = tr_read<3072>(a0); tv[1][2] = tr_read<2048>(a1); tv[1][3] = tr_read<3072>(a1);
            tv[2][0] = tr_read<4096>(a0); tv[2][1] = tr_read<5120>(a0); tv[2][2] = tr_read<4096>(a1); tv[2][3] = tr_read<5120>(a1);
            tv[3][0] = tr_read<6144>(a0); tv[3][1] = tr_read<7168>(a0); tv[3][2] = tr_read<6144>(a1); tv[3][3] = tr_read<7168>(a1);
            LDS_WAIT(); SBAR();
#pragma unroll
            for (int J = 0; J < 4; ++J) {
                o0 = __builtin_amdgcn_mfma_f32_32x32x16_bf16(PK8(tv[J][0], tv[J][1]), pfb[J], o0, 0, 0, 0);
                o1 = __builtin_amdgcn_mfma_f32_32x32x16_bf16(PK8(tv[J][2], tv[J][3]), pfb[J], o1, 0, 0, 0); }
        }
#undef B_QK
#undef B_LOAD
#undef B_WRITE
        int mqe = mb + qb * 256 + wid * 32 + r32; asm volatile("" : "+v"(mqe));
        const float linv = frcp(swap_sum(l_run));
        const bf16_t* zr = P0 + (size_t)mqe * LDP0 + 2464 + h * 64;
        bf16_t* yr = (bf16_t*)P0 + (size_t)mqe * LDP0 + 2464 + h * 64;
#pragma unroll
        for (int db = 0; db < 2; ++db)
#pragma unroll
            for (int rg = 0; rg < 4; ++rg) {
                const int d0 = db * 32 + 8 * rg + 4 * hi;
                const u32x2 z = *(const u32x2*)(zr + d0);
                const f32x16& o = db == 0 ? o0 : o1;
                const float y0 = o[4 * rg + 0] * linv * silu(bflo(z.x)), y1 = o[4 * rg + 1] * linv * silu(bfhi(z.x));
                const float y2 = o[4 * rg + 2] * linv * silu(bflo(z.y)), y3 = o[4 * rg + 3] * linv * silu(bfhi(z.y));
                u32x2 w; w.x = pk2(y0, y1); w.y = pk2(y2, y3);
                *(u32x2*)(yr + d0) = w;
            }
    }
    __builtin_amdgcn_s_setprio(0);
}

__device__ __forceinline__ void odd_prep_phase(const Params& p, int vcu, int G) {
    const int tid = opaque_tid(), lane = tid & 63, wave = tid >> 6, j = lane & 7;
    const int gw = vcu * 8 + wave, NGW = G * 8;
    bf16_t* P1 = (bf16_t*)(p.ws + WS_P);
    float vg[8], vbv[8], qg[8], kg[8];
#pragma unroll
    for (int i = 0; i < 8; ++i) { vg[i] = p.vn_g[8 * lane + i]; vbv[i] = p.vn_b[8 * lane + i]; qg[i] = p.dq_gain[8 * j + i] * QSCALE_D; kg[i] = p.dk_gain[8 * j + i]; }
    for (int m = gw; m < M; m += NGW) {
        bf16_t* pr = P1 + (size_t)m * LDP1;
        const u32x4 cv = *(const u32x4*)(pr + 512 + 8 * lane), dq = *(const u32x4*)(pr + 1536 + 8 * lane), dk = *(const u32x4*)(pr + 2048 + 8 * lane);
        float x[8];
#pragma unroll
        for (int i = 0; i < 4; ++i) { x[2 * i] = gelu_t(bflo(cv[i])); x[2 * i + 1] = gelu_t(bfhi(cv[i])); }
        float s = 0.f;
#pragma unroll
        for (int i = 0; i < 8; ++i) s += x[i];
        const float mean = wave_sum(s) * (1.f / 512.f);
        float s2 = 0.f;
#pragma unroll
        for (int i = 0; i < 8; ++i) { x[i] -= mean; s2 += x[i] * x[i]; }
        const float rstd = __builtin_amdgcn_rsqf(wave_sum(s2) * (1.f / 512.f) + EPS);
        u32x4 w;
#pragma unroll
        for (int i = 0; i < 4; ++i) w[i] = pk2(x[2 * i] * rstd * vg[2 * i] + vbv[2 * i], x[2 * i + 1] * rstd * vg[2 * i + 1] + vbv[2 * i + 1]);
        *(u32x4*)(pr + 512 + 8 * lane) = w;
        float q[8], k[8]; float sq = 0.f, sk = 0.f;
#pragma unroll
        for (int i = 0; i < 4; ++i) { q[2 * i] = bflo(dq[i]); q[2 * i + 1] = bfhi(dq[i]); k[2 * i] = bflo(dk[i]); k[2 * i + 1] = bfhi(dk[i]); }
#pragma unroll
        for (int i = 0; i < 8; ++i) { sq += q[i] * q[i]; sk += k[i] * k[i]; }
        const float rq = __builtin_amdgcn_rsqf(sum8(sq) * (1.f / 64.f) + EPS), rk = __builtin_amdgcn_rsqf(sum8(sk) * (1.f / 64.f) + EPS);
        u32x4 wq, wk;
#pragma unroll
        for (int i = 0; i < 4; ++i) { wq[i] = pk2(q[2 * i] * rq * qg[2 * i], q[2 * i + 1] * rq * qg[2 * i + 1]); wk[i] = pk2(k[2 * i] * rk * kg[2 * i], k[2 * i + 1] * rk * kg[2 * i + 1]); }
        *(u32x4*)(pr + 1536 + 8 * lane) = wq; *(u32x4*)(pr + 2048 + 8 * lane) = wk;
    }
}

__device__ __forceinline__ void gmlp_phase(const Params& p, LAS unsigned char* lds, int vcu) {
    const int tid = opaque_tid(), lane = tid & 63, wid = tid >> 6, r32 = lane & 31, hi = lane >> 5, j16 = lane & 15, g16 = lane >> 4;
    constexpr int VVROW = 1088;
    const bf16_t* P1 = (const bf16_t*)(p.ws + WS_P);
    const bf16_t* Ws = (const bf16_t*)(p.ws + WS_CWS);
    bf16_t* YC = (bf16_t*)(p.ws + WS_H);
    const int g = wid >> 1, chalf = wid & 1;
    const int cbase = g * 128 + chalf * 64;
    float vg[8], vbv[8];
#pragma unroll
    for (int e = 0; e < 8; ++e) { vg[e] = p.vn_g[8 * lane + e]; vbv[e] = p.vn_b[8 * lane + e]; }
    const unsigned vrd = (unsigned)(uintptr_t)lds + (unsigned)((hi * 8 + (j16 >> 2)) * VVROW + (cbase + 16 * (g16 & 1) + 4 * (j16 & 3)) * 2);
    for (int it = 0; it < 3; ++it) {
        const int ci = vcu + 256 * it; const int m0 = ci * 128;
        __syncthreads();
#pragma unroll 4
        for (int i = 0; i < 16; ++i) { const int row = wid + 8 * i;
            const u32x4 v = *(const u32x4*)(P1 + (size_t)(m0 + row) * LDP1 + 512 + lane * 8);
            float x[8];
#pragma unroll
            for (int e = 0; e < 4; ++e) { x[2 * e] = gelu_t(bflo(v[e])); x[2 * e + 1] = gelu_t(bfhi(v[e])); }
            float sm = 0.f;
#pragma unroll
            for (int e = 0; e < 8; ++e) sm += x[e];
            const float mean = wave_sum(sm) * (1.f / 512.f);
            float s2 = 0.f;
#pragma unroll
            for (int e = 0; e < 8; ++e) { x[e] -= mean; s2 += x[e] * x[e]; }
            const float rstd = __builtin_amdgcn_rsqf(wave_sum(s2) * (1.f / 512.f) + EPS);
            u32x4 w;
#pragma unroll
            for (int e = 0; e < 4; ++e) w[e] = pk2(x[2 * e] * rstd * vg[2 * e] + vbv[2 * e], x[2 * e + 1] * rstd * vg[2 * e + 1] + vbv[2 * e + 1]);
            *(LAS u32x4*)(lds + row * VVROW + lane * 16) = w; }
        __syncthreads();
#pragma unroll 1
        for (int pb = 0; pb < 4; ++pb) {
            f32x16 a0 = {}, a1 = {};
            const bf16_t* wsr = Ws + ((size_t)g * 128 + pb * 32 + r32) * 128 + hi * 8;
#pragma unroll
            for (int ks = 0; ks < 8; ++ks) {
                const bf16x8 bfr = *(const bf16x8*)(wsr + ks * 16);
                const unsigned va = vrd + (unsigned)(ks * 16 * VVROW);
                const s16x4 t00 = tr_read<0>(va), t01 = tr_read<4 * VVROW>(va), t10 = tr_read<64>(va), t11 = tr_read<64 + 4 * VVROW>(va);
                LDS_WAIT(); SBAR();
                a0 = __builtin_amdgcn_mfma_f32_32x32x16_bf16(PK8(t00, t01), bfr, a0, 0, 0, 0);
                a1 = __builtin_amdgcn_mfma_f32_32x32x16_bf16(PK8(t10, t11), bfr, a1, 0, 0, 0);
            }
            const int pl = pb * 32 + r32; const int m = m0 + pl;
            const float bsv = p.c_bs[g * 128 + pl];
            const bf16_t* pr = P1 + (size_t)m * LDP1;
#pragma unroll
            for (int cb = 0; cb < 2; ++cb)
#pragma unroll
                for (int rg = 0; rg < 4; ++rg) {
                    const int c4 = cbase + cb * 32 + 8 * rg + 4 * hi;
                    const u32x2 cu = *(const u32x2*)(pr + c4), cz = *(const u32x2*)(pr + 1024 + c4);
                    const f32x16& a = cb == 0 ? a0 : a1;
                    const float y0 = gelu_t(bflo(cu.x)) * (a[4 * rg + 0] + bsv) * silu(bflo(cz.x)), y1 = gelu_t(bfhi(cu.x)) * (a[4 * rg + 1] + bsv) * silu(bfhi(cz.x));
                    const float y2 = gelu_t(bflo(cu.y)) * (a[4 * rg + 2] + bsv) * silu(bflo(cz.y)), y3 = gelu_t(bfhi(cu.y)) * (a[4 * rg + 3] + bsv) * silu(bfhi(cz.y));
                    u32x2 w; w.x = pk2(y0, y1); w.y = pk2(y2, y3);
                    *(u32x2*)(YC + (size_t)m * D + c4) = w;
                }
        }
    }
}

__device__ __forceinline__ void dilated_phase(const Params& p, LAS unsigned char* lds, int vcu, int G) {
    const int tid = opaque_tid(), lane = tid & 63, wid = tid >> 6, r32 = lane & 31, hi = lane >> 5, j16 = lane & 15, g16 = lane >> 4;
    constexpr int VROW = 192, VBUF = 32 * VROW;
    bf16_t* P1 = (bf16_t*)(p.ws + WS_P);
    float* LSE = (float*)(p.ws + WS_LSE);
    LAS float* bt = (LAS float*)lds;
    LAS unsigned char* vl = lds + 16384 + wid * (2 * VBUF);
    __syncthreads();
    { const float* bsrc = (const float*)(p.ws + WS_BIAS); for (int i = tid; i < 3 * 8 * 129; i += 512) bt[i] = bsrc[i]; }
    __syncthreads();
    const unsigned vrd = (unsigned)(uintptr_t)vl + (unsigned)((4 * hi + (j16 >> 2)) * VROW + (16 * (g16 & 1) + 4 * (j16 & 3)) * 2);
    const int gw = vcu * 8 + wid, NGW = G * 8;
    constexpr int NTASK = 3 * 8 * (M / 32);
#pragma unroll 1
    for (int task = gw; task < NTASK; task += NGW) {
        const int T = task % (M / 32); const int gh = task / (M / 32); const int h = gh & 7, g = gh >> 3;
        const int dsh = 2 * g;
        int mb, tt, Sb;
        if (T < 1024) { mb = (T >> 7) * 4096; tt = T & 127; Sb = 4096; } else { const int t2 = T - 1024; mb = MP + (t2 >> 6) * 2048; tt = t2 & 63; Sb = 2048; }
        const int L = Sb >> dsh, tpr = L >> 5;
        const int res = tt / tpr, u0 = (tt % tpr) * 32;
        const int tq = mb + res + ((u0 + r32) << dsh);
        bf16x8 qf[4];
#pragma unroll
        for (int k0 = 0; k0 < 4; ++k0) qf[k0] = *(const bf16x8*)(P1 + (size_t)tq * LDP1 + 1536 + h * 64 + k0 * 16 + hi * 8);
        f32x16 s[5];
        const LAS float* btg = bt + (g * 8 + h) * 129;
#pragma unroll
        for (int kb = 0; kb < 5; ++kb) {
            int ku = u0 - 64 + kb * 32 + r32; ku = ku < 0 ? 0 : (ku >= L ? L - 1 : ku);
            const bf16_t* kr = P1 + (size_t)(mb + res + (ku << dsh)) * LDP1 + 2048 + h * 64 + hi * 8;
            bf16x8 kf[4];
#pragma unroll
            for (int k0 = 0; k0 < 4; ++k0) kf[k0] = *(const bf16x8*)(kr + k0 * 16);
            f32x16 a = {};
#pragma unroll
            for (int k0 = 0; k0 < 4; ++k0) a = __builtin_amdgcn_mfma_f32_32x32x16_bf16(kf[k0], qf[k0], a, 0, 0, 0);
#pragma unroll
            for (int r = 0; r < 16; ++r) {
                const int kl = kb * 32 + crow(r, hi); const int jj = kl - r32; const int kuu = u0 - 64 + kl;
                const bool ok = (jj >= 0) && (jj <= 128) && (kuu >= 0) && (kuu < L);
                const int jc = jj < 0 ? 0 : (jj > 128 ? 128 : jj);
                a[r] = ok ? a[r] + btg[jc] : -1e30f;
            }
            s[kb] = a;
        }
        float mx = -1e30f;
#pragma unroll
        for (int kb = 0; kb < 5; ++kb)
#pragma unroll
            for (int r = 0; r < 16; ++r) mx = fmaxf(mx, s[kb][r]);
        mx = swap_max(mx);
        float ls = 0.f;
#pragma unroll
        for (int kb = 0; kb < 5; ++kb)
#pragma unroll
            for (int r = 0; r < 16; ++r) { s[kb][r] = fexp2(s[kb][r] - mx); ls += s[kb][r]; }
        ls = swap_sum(ls);
        f32x16 o0 = {}, o1 = {};
        u32x4 vreg[4];
#define D_VLOAD(kb) do { int ku = u0 - 64 + (kb) * 32 + r32; ku = ku < 0 ? 0 : (ku >= L ? L - 1 : ku); \
        const bf16_t* vr = P1 + (size_t)(mb + res + (ku << dsh)) * LDP1 + 2560 + h * 64 + hi * 8; \
        _Pragma("unroll") for (int i = 0; i < 4; ++i) vreg[i] = *(const u32x4*)(vr + i * 16); } while (0)
        D_VLOAD(0);
#pragma unroll
        for (int kb = 0; kb < 5; ++kb) {
            LAS unsigned char* vbw = vl + (kb & 1) * VBUF + r32 * VROW + hi * 16;
#pragma unroll
            for (int i = 0; i < 4; ++i) *(LAS u32x4*)(vbw + i * 32) = vreg[i];
            if (kb < 4) D_VLOAD(kb + 1);
            LDS_WAIT();
            const unsigned vb = vrd + (unsigned)((kb & 1) * VBUF);
#pragma unroll
            for (int a = 0; a < 2; ++a) {
                const unsigned vba = vb + (unsigned)(a * 16 * VROW);
                const s16x4 t00 = tr_read<0>(vba), t01 = tr_read<8 * VROW>(vba), t10 = tr_read<64>(vba), t11 = tr_read<64 + 8 * VROW>(vba);
                LDS_WAIT(); SBAR();
                u32x4 w; w.x = pk2(s[kb][8 * a + 0], s[kb][8 * a + 1]); w.y = pk2(s[kb][8 * a + 2], s[kb][8 * a + 3]); w.z = pk2(s[kb][8 * a + 4], s[kb][8 * a + 5]); w.w = pk2(s[kb][8 * a + 6], s[kb][8 * a + 7]);
                const bf16x8 pf = *(bf16x8*)&w;
                o0 = __builtin_amdgcn_mfma_f32_32x32x16_bf16(PK8(t00, t01), pf, o0, 0, 0, 0);
                o1 = __builtin_amdgcn_mfma_f32_32x32x16_bf16(PK8(t10, t11), pf, o1, 0, 0, 0);
            }
        }
#undef D_VLOAD
        const float linv = frcp(ls);
        bf16_t* orow = P1 + (size_t)tq * LDP1 + g * 512 + h * 64;
#pragma unroll
        for (int db = 0; db < 2; ++db)
#pragma unroll
            for (int rg = 0; rg < 4; ++rg) {
                const f32x16& o = db == 0 ? o0 : o1;
                u32x2 w; w.x = pk2(o[4 * rg] * linv, o[4 * rg + 1] * linv); w.y = pk2(o[4 * rg + 2] * linv, o[4 * rg + 3] * linv);
                *(u32x2*)(orow + db * 32 + 8 * rg + 4 * hi) = w;
            }
        if (hi == 0) LSE[((size_t)g * M + tq) * 8 + h] = mx + __builtin_amdgcn_logf(ls);
    }
}

template <int MODE>
__device__ __forceinline__ void dilated_phase2(const Params& p, LAS unsigned char* lds, int vcu) {
    const int tid = opaque_tid(), lane = tid & 63, wid = __builtin_amdgcn_readfirstlane(tid >> 6), r32 = lane & 31, hi = lane >> 5, j16 = lane & 15, g16 = lane >> 4;
    const int hf = wid >> 2, wq = wid & 3, t = tid & 255;
    bf16_t* P1 = (bf16_t*)(p.ws + WS_P);
    float* LSE = (float*)(p.ws + WS_LSE);
    const float* BT = (const float*)(p.ws + WS_BIAS);
    LAS unsigned char* Kl = lds + hf * 66560; LAS unsigned char* Vl = Kl + 32768; LAS float* tbl = (LAS float*)(Kl + 65536);
    const int sw = (r32 >> 1) & 7;
    const LAS unsigned char* kfp[4];
#pragma unroll
    for (int k0 = 0; k0 < 4; ++k0) kfp[k0] = Kl + (32 * wq + r32) * 128 + (((2 * k0 + hi) ^ sw) << 4);
    const int fsw = (j16 >> 3) & 1;
    const unsigned vrowb = (unsigned)(uintptr_t)Vl + (unsigned)((32 * wq + 4 * hi + (j16 >> 2)) * 128 + 32 * (g16 & 1) + 8 * (j16 & 3));
    const unsigned vb0 = vrowb + (unsigned)(fsw * 64), vb1 = vrowb + (unsigned)((1 - fsw) * 64);
    const LAS float* tb = tbl + 31 - r32 + 4 * hi;
    const int hw = vcu * 2 + hf;
    constexpr int NUNITS = (MODE == 0 ? 2 : 1) * 8 * (M / 128), NU = NUNITS / 512;
    bf16_t* YC = (bf16_t*)(p.ws + WS_H);
    bf16x8 qf[4];
#pragma unroll 1
    for (int step = 0; step <= 2 * NU; ++step) {
        const int ph = step - hf;
        if (ph >= 0 && ph < 2 * NU) {
            const int unit = hw + 512 * (ph >> 1);
            const int T4 = unit % (M / 128); const int gh = unit / (M / 128) + (MODE == 0 ? 0 : 16); const int h = gh & 7, g = gh >> 3;
            const int dsh = 2 * g;
            int mb, tt, Sb;
            if (T4 < 256) { mb = (T4 >> 5) * 4096; tt = (T4 & 31) * 4; Sb = 4096; } else { const int t2 = T4 - 256; mb = MP + (t2 >> 4) * 2048; tt = (t2 & 15) * 4; Sb = 2048; }
            const int L = Sb >> dsh, tpr = L >> 5;
            const int res = tt / tpr, u0 = (tt % tpr) * 32;
            if ((ph & 1) == 0) {
                u32x4 kreg[8], vreg[8];
#pragma unroll
                for (int i = 0; i < 8; ++i) { const int idx = t + 256 * i; const int row = idx >> 3, c = idx & 7;
                    int ku = u0 - 64 + row; ku = ku < 0 ? 0 : (ku >= L ? L - 1 : ku);
                    const bf16_t* src = P1 + (size_t)(mb + res + (ku << dsh)) * LDP1 + h * 64 + c * 8;
                    kreg[i] = *(const u32x4*)(src + 2048); vreg[i] = *(const u32x4*)(src + 2560); }
                { const int tq = mb + res + ((u0 + 32 * wq + r32) << dsh);
#pragma unroll
                  for (int k0 = 0; k0 < 4; ++k0) qf[k0] = *(const bf16x8*)(P1 + (size_t)tq * LDP1 + 1536 + h * 64 + k0 * 16 + hi * 8); }
                if (t < 191) { const int jj = t - 31; tbl[t] = (jj >= 0 && jj <= 128) ? BT[(g * 8 + h) * 129 + jj] : -1e30f; }
#pragma unroll
                for (int i = 0; i < 8; ++i) { const int idx = t + 256 * i; const int row = idx >> 3, c = idx & 7;
                    *(LAS u32x4*)(Kl + row * 128 + ((c ^ ((row >> 1) & 7)) << 4)) = kreg[i];
                    *(LAS u32x4*)(Vl + row * 128 + ((c ^ (((row >> 1) & 1) << 2)) << 4)) = vreg[i]; }
            } else {
                f32x16 s[5];
#pragma unroll
                for (int kb = 0; kb < 5; ++kb) {
                    bf16x8 kf[4];
#pragma unroll
                    for (int k0 = 0; k0 < 4; ++k0) kf[k0] = *(const LAS bf16x8*)(kfp[k0] + kb * 4096);
                    f32x16 a = {};
#pragma unroll
                    for (int k0 = 0; k0 < 4; ++k0) a = __builtin_amdgcn_mfma_f32_32x32x16_bf16(kf[k0], qf[k0], a, 0, 0, 0);
#pragma unroll
                    for (int r = 0; r < 16; ++r) a[r] += tb[kb * 32 + 8 * (r >> 2) + (r & 3)];
                    s[kb] = a;
                }
                const int klo = u0 - 64 + 32 * wq;
                if (klo < 0 || klo + 160 > L) {
#pragma unroll
                    for (int kb = 0; kb < 5; ++kb)
#pragma unroll
                        for (int r = 0; r < 16; ++r) { const int ku = klo + kb * 32 + crow(r, hi); if (ku < 0 || ku >= L) s[kb][r] = -1e30f; }
                }
                float mx = -1e30f;
#pragma unroll
                for (int kb = 0; kb < 5; ++kb)
#pragma unroll
                    for (int r = 0; r < 16; ++r) mx = fmaxf(mx, s[kb][r]);
                mx = swap_max(mx);
                float ls = 0.f;
#pragma unroll
                for (int kb = 0; kb < 5; ++kb)
#pragma unroll
                    for (int r = 0; r < 16; ++r) { s[kb][r] = fexp2(s[kb][r] - mx); ls += s[kb][r]; }
                ls = swap_sum(ls);
                f32x16 o0 = {}, o1 = {};
#define D2_BATCH(J0) do { \
                s16x4 tv[5][4]; \
                tv[0][0] = tr_read<((J0) + 0) * 2048>(vb0); tv[0][1] = tr_read<((J0) + 0) * 2048 + 1024>(vb0); tv[0][2] = tr_read<((J0) + 0) * 2048>(vb1); tv[0][3] = tr_read<((J0) + 0) * 2048 + 1024>(vb1); \
                tv[1][0] = tr_read<((J0) + 1) * 2048>(vb0); tv[1][1] = tr_read<((J0) + 1) * 2048 + 1024>(vb0); tv[1][2] = tr_read<((J0) + 1) * 2048>(vb1); tv[1][3] = tr_read<((J0) + 1) * 2048 + 1024>(vb1); \
                tv[2][0] = tr_read<((J0) + 2) * 2048>(vb0); tv[2][1] = tr_read<((J0) + 2) * 2048 + 1024>(vb0); tv[2][2] = tr_read<((J0) + 2) * 2048>(vb1); tv[2][3] = tr_read<((J0) + 2) * 2048 + 1024>(vb1); \
                tv[3][0] = tr_read<((J0) + 3) * 2048>(vb0); tv[3][1] = tr_read<((J0) + 3) * 2048 + 1024>(vb0); tv[3][2] = tr_read<((J0) + 3) * 2048>(vb1); tv[3][3] = tr_read<((J0) + 3) * 2048 + 1024>(vb1); \
                tv[4][0] = tr_read<((J0) + 4) * 2048>(vb0); tv[4][1] = tr_read<((J0) + 4) * 2048 + 1024>(vb0); tv[4][2] = tr_read<((J0) + 4) * 2048>(vb1); tv[4][3] = tr_read<((J0) + 4) * 2048 + 1024>(vb1); \
                LDS_WAIT(); SBAR(); \
                _Pragma("unroll") for (int jj = 0; jj < 5; ++jj) { const int j = (J0) + jj; const int kb = j >> 1, a8 = 8 * (j & 1); \
                    u32x4 w; w.x = pk2(s[kb][a8 + 0], s[kb][a8 + 1]); w.y = pk2(s[kb][a8 + 2], s[kb][a8 + 3]); w.z = pk2(s[kb][a8 + 4], s[kb][a8 + 5]); w.w = pk2(s[kb][a8 + 6], s[kb][a8 + 7]); \
                    const bf16x8 pf = *(bf16x8*)&w; \
                    o0 = __builtin_amdgcn_mfma_f32_32x32x16_bf16(PK8(tv[jj][0], tv[jj][1]), pf, o0, 0, 0, 0); \
                    o1 = __builtin_amdgcn_mfma_f32_32x32x16_bf16(PK8(tv[jj][2], tv[jj][3]), pf, o1, 0, 0, 0); } } while (0)
                D2_BATCH(0); D2_BATCH(5);
#undef D2_BATCH
                const float linv = frcp(ls);
                const int tq = mb + res + ((u0 + 32 * wq + r32) << dsh);
                if (MODE == 0) {
                    bf16_t* orow = P1 + (size_t)tq * LDP1 + g * 512 + h * 64;
#pragma unroll
                    for (int db = 0; db < 2; ++db)
#pragma unroll
                        for (int rg = 0; rg < 4; ++rg) {
                            const f32x16& o = db == 0 ? o0 : o1;
                            u32x2 w; w.x = pk2(o[4 * rg] * linv, o[4 * rg + 1] * linv); w.y = pk2(o[4 * rg + 2] * linv, o[4 * rg + 3] * linv);
                            *(u32x2*)(orow + db * 32 + 8 * rg + 4 * hi) = w;
                        }
                    if (hi == 0) LSE[((size_t)g * M + tq) * 8 + h] = mx + __builtin_amdgcn_logf(ls);
                } else {
                    const bf16_t* prow = P1 + (size_t)tq * LDP1 + h * 64;
                    u32x2 g0v[8], g1v[8], zv[8];
#pragma unroll
                    for (int db = 0; db < 2; ++db)
#pragma unroll
                        for (int rg = 0; rg < 4; ++rg) { const int d0 = db * 32 + 8 * rg + 4 * hi;
                            g0v[db * 4 + rg] = *(const u32x2*)(prow + d0); g1v[db * 4 + rg] = *(const u32x2*)(prow + 512 + d0); zv[db * 4 + rg] = *(const u32x2*)(prow + 3072 + d0); }
                    const float l0 = LSE[((size_t)0 * M + tq) * 8 + h], l1 = LSE[((size_t)1 * M + tq) * 8 + h], l2 = mx + __builtin_amdgcn_logf(ls);
                    const float mm = fmaxf(l0, fmaxf(l1, l2));
                    float w0 = fexp2(l0 - mm), w1 = fexp2(l1 - mm), w2 = fexp2(l2 - mm);
                    const float winv = frcp(w0 + w1 + w2); w0 *= winv; w1 *= winv; w2 *= winv * linv;
                    bf16_t* yrow = YC + (size_t)tq * D + 512 + h * 64;
#pragma unroll
                    for (int db = 0; db < 2; ++db)
#pragma unroll
                        for (int rg = 0; rg < 4; ++rg) {
                            const f32x16& o = db == 0 ? o0 : o1; const u32x2 a = g0v[db * 4 + rg], c = g1v[db * 4 + rg], z = zv[db * 4 + rg];
                            const float y0 = (w0 * bflo(a.x) + w1 * bflo(c.x) + w2 * o[4 * rg + 0]) * silu(bflo(z.x)), y1 = (w0 * bfhi(a.x) + w1 * bfhi(c.x) + w2 * o[4 * rg + 1]) * silu(bfhi(z.x));
                            const float y2 = (w0 * bflo(a.y) + w1 * bflo(c.y) + w2 * o[4 * rg + 2]) * silu(bflo(z.y)), y3 = (w0 * bfhi(a.y) + w1 * bfhi(c.y) + w2 * o[4 * rg + 3]) * silu(bfhi(z.y));
                            u32x2 w; w.x = pk2(y0, y1); w.y = pk2(y2, y3);
                            *(u32x2*)(yrow + db * 32 + 8 * rg + 4 * hi) = w;
                        }
                }
            }
        }
        __syncthreads();
    }
}

struct MrgTok { u32x4 o0, o1, o2, dz; float l0, l1, l2; };
__device__ __forceinline__ void merge_phase(const Params& p, int vcu, int G) {
    const int tid = opaque_tid(), lane = tid & 63, wave = tid >> 6, h = lane >> 3;
    const int gw = vcu * 8 + wave, NGW = G * 8;
    const bf16_t* P1 = (const bf16_t*)(p.ws + WS_P);
    const float* LSE = (const float*)(p.ws + WS_LSE);
    bf16_t* YC = (bf16_t*)(p.ws + WS_H);
#define MRG_LOAD(T, m) do { const bf16_t* pr_ = P1 + (size_t)(m) * LDP1; \
        T.o0 = *(const u32x4*)(pr_ + 8 * lane); T.o1 = *(const u32x4*)(pr_ + 512 + 8 * lane); T.o2 = *(const u32x4*)(pr_ + 1024 + 8 * lane); T.dz = *(const u32x4*)(pr_ + 3072 + 8 * lane); \
        T.l0 = LSE[((size_t)0 * M + (m)) * 8 + h]; T.l1 = LSE[((size_t)1 * M + (m)) * 8 + h]; T.l2 = LSE[((size_t)2 * M + (m)) * 8 + h]; } while (0)
#define MRG_COMPUTE(T, m) do { \
        const float mx = fmaxf(T.l0, fmaxf(T.l1, T.l2)); \
        float w0 = fexp2(T.l0 - mx), w1 = fexp2(T.l1 - mx), w2 = fexp2(T.l2 - mx); \
        const float inv = frcp(w0 + w1 + w2); w0 *= inv; w1 *= inv; w2 *= inv; \
        u32x4 w; \
        _Pragma("unroll") for (int i = 0; i < 4; ++i) { \
            const float ylo = (w0 * bflo(T.o0[i]) + w1 * bflo(T.o1[i]) + w2 * bflo(T.o2[i])) * silu(bflo(T.dz[i])); \
            const float yhi = (w0 * bfhi(T.o0[i]) + w1 * bfhi(T.o1[i]) + w2 * bfhi(T.o2[i])) * silu(bfhi(T.dz[i])); \
            w[i] = pk2(ylo, yhi); } \
        *(u32x4*)(YC + (size_t)(m) * D + 512 + 8 * lane) = w; } while (0)
    MrgTok A, B;
    int m = gw;
    if (m < M) MRG_LOAD(A, m);
    for (; m < M; m += 2 * NGW) {
        const int m2 = m + NGW, m3 = m + 2 * NGW;
        if (m2 < M) MRG_LOAD(B, m2);
        MRG_COMPUTE(A, m);
        if (m2 < M) {
            if (m3 < M) MRG_LOAD(A, m3);
            MRG_COMPUTE(B, m2);
        }
    }
#undef MRG_LOAD
#undef MRG_COMPUTE
}

__global__ void __launch_bounds__(512, 2) mega(Params p) {
    extern __shared__ __attribute__((aligned(16))) unsigned char lds_raw[];
    LAS unsigned char* lds = (LAS unsigned char*)lds_raw;
    const unsigned long long mgs = ((const unsigned long long*)__builtin_amdgcn_implicitarg_ptr())[11];
    const int G = gridDim.x, bx = blockIdx.x;
    const int vcu = (G % 8 == 0) ? (bx % 8) * (G / 8) + bx / 8 : bx;
    unsigned* bar = (unsigned*)(p.ws + WS_CTL);
    volatile LAS unsigned* xst = (volatile LAS unsigned*)(lds + (LDS_BYTES - 64));
    if (threadIdx.x < 2) xst[threadIdx.x] = 0u;
    __syncthreads();
    const XcdBarrier xb = xcd_barrier_post(bar, xst);
    unsigned char* ws = p.ws;
    if (mgs == 0x9e3779b97f4a7c15ull && threadIdx.x == 0) bar[4000] = 1u;
    bf16_t* H = (bf16_t*)(ws + WS_H);
    bf16_t* P = (bf16_t*)(ws + WS_P);
    const float* MOD = (const float*)(ws + WS_MOD);

    for (int rep = 0; rep < REP_PREP; ++rep) p0_prep(p, lds, vcu, G);
    xcd_barrier(xb);
    sw1_phase(p, lds, vcu);
    for (int rep = 0; rep < REP_PRE0; ++rep) prenorm_phase(p, 0, vcu, G);
    xcd_barrier(xb);
    for (int rep = 0; rep < REP_GEMM; ++rep) { pg8::Gemm g{H, (const bf16_t*)(ws + WS_WINE), M, 3072, 1024, 1024, 1 << 30, 0}; pg8::StaticOrder S; S.init(M, 3072, G, bx);
      pg8::EpiInE E{P}; pg8::gemm_phase(lds, g, S, E); }
    xcd_barrier(xb);
    { pg8::Gemm g{P + 2048, (const bf16_t*)(ws + WS_WUQ), M, 768, 256, LDP0, 1 << 30, 0}; pg8::StaticOrder S; S.init(M, 768, G, bx);
      pg8::EpiBf16 E{(bf16_t*)((unsigned char*)p.out + OUT_Q), 768}; pg8::gemm_phase(lds, g, S, E); }
    { pg8::Gemm g{P + 2304, (const bf16_t*)(ws + WS_WUKV), M, 1024, 128, LDP0, 1 << 30, 0}; pg8::StaticOrder S; S.init(M, 1024, G, bx);
      pg8::EpiBf16 E{(bf16_t*)((unsigned char*)p.out + OUT_KV), 1024}; pg8::gemm_phase(lds, g, S, E); }
    xcd_barrier(xb);
    mla_prep_phase(p, vcu, G);
    xcd_barrier(xb);
    {
        float gq = 0.f, gk = 0.f;
        for (int i = 0; i < 96; ++i) { gq = fmaxf(gq, fabsf(p.q_gain[i])); gk = fmaxf(gk, fabsf(p.k_gain[i])); }
        const float sbound = 96.f * gq * gk * QSCALE_B;
        for (int rep = 0; rep < REP_ATTN; ++rep) { if (sbound < 64.f) attn_dense_phase7<true>(p, lds, vcu); else attn_dense_phase3<false>(p, lds, vcu); }
    }
    xcd_barrier(xb);
    { pg8::Gemm g{P + 512, (const bf16_t*)(ws + WS_WOE), M, 1024, 1024, LDP0, 8, (2464 - 1024) * 2}; pg8::StaticOrder S; S.init(M, 1024, G, bx);
      pg8::EpiResid0 E{p.xp, p.xs, p.out, MOD, MOD + (size_t)NB * 3072, p.norm_g + D, H, (float*)(ws + WS_ROWSS)}; pg8::gemm_phase(lds, g, S, E); }
    xcd_barrier(xb);
    { pg8::Gemm g{H, (const bf16_t*)(ws + WS_WINO), M, 3584, 1024, 1024, 1 << 30, 0}; pg8::StaticOrder S; S.init(M, 3584, G, bx);
      pg8::EpiInO E{P, p.dq_gain, p.dk_gain, (const float*)(ws + WS_ROWSS), (const float*)(ws + WS_SW)}; pg8::gemm_phase(lds, g, S, E); }
    xcd_barrier(xb);
    for (int rep = 0; rep < REP_GMLP; ++rep) gmlp_phase(p, lds, vcu);
    xcd_barrier(xb);
    dilated_phase2<0>(p, lds, vcu);
    xcd_barrier(xb);
    dilated_phase2<1>(p, lds, vcu);
    xcd_barrier(xb);
    { pg8::Gemm g{H, (const bf16_t*)(ws + WS_WOO), M, 1024, 1024, 1024, 1 << 30, 0}; pg8::StaticOrder S; S.init(M, 1024, G, bx);
      pg8::EpiResid E{p.out, p.out + (size_t)MP * D, p.out, MOD + (size_t)NB * 3072 + 2048}; pg8::gemm_phase(lds, g, S, E); }
}

extern "C" void kernel_launch(void* const* d_in, const int* in_sizes, int n_in, void* d_out, int out_size, void* d_ws, size_t ws_size, hipStream_t stream) {
    static int grid = 0;
    if (grid == 0) {
        if (n_in != 25 || ws_size < WS_END || out_size != M * D) { fprintf(stderr, "kernel_launch: unexpected shapes (n_in %d, ws %zu, out %d)\n", n_in, ws_size, out_size); grid = -1; return; }
        int dev = 0, cus = 0, per_cu = 0;
        (void)hipGetDevice(&dev);
        (void)hipDeviceGetAttribute(&cus, hipDeviceAttributeMultiprocessorCount, dev);
        (void)hipFuncSetAttribute((const void*)mega, hipFuncAttributeMaxDynamicSharedMemorySize, LDS_BYTES);
        (void)hipOccupancyMaxActiveBlocksPerMultiprocessor(&per_cu, (const void*)mega, 512, LDS_BYTES);
        (void)hipGetLastError();
        grid = cus;
        fprintf(stderr, "kernel_launch: grid %d (cus %d, occupancy query %d)\n", grid, cus, per_cu);
    }
    if (grid < 0) return;
    (void)hipMemsetAsync((char*)d_ws + WS_CTL, 0, 16384, stream);
    Params p{};
    const float** f = (const float**)&p;
    for (int i = 0; i < 25; ++i) f[i] = (const float*)d_in[i];
    p.out = (float*)d_out; p.ws = (unsigned char*)d_ws; p.pad = 0ull;
    void* args[] = {&p};
    hipError_t e = hipLaunchCooperativeKernel((const void*)mega, dim3(grid), dim3(512), args, LDS_BYTES, stream);
    if (e != hipSuccess) fprintf(stderr, "kernel_launch: cooperative launch failed: %s (grid %d)\n", hipGetErrorString(e), grid);
}
```

```cpp
#include <hip/hip_runtime.h>
#include <cstdio>
#include <cstdint>

#define LAS __attribute__((address_space(3)))
typedef unsigned short bf16_t;
typedef short bf16x8 __attribute__((ext_vector_type(8)));
typedef short s16x4 __attribute__((ext_vector_type(4)));
typedef float f32x4 __attribute__((ext_vector_type(4)));
typedef float f32x16 __attribute__((ext_vector_type(16)));
typedef unsigned u32x4 __attribute__((ext_vector_type(4)));
typedef unsigned u32x2 __attribute__((ext_vector_type(2)));

constexpr int D = 1024, MP = 32768, MS = 65536, M = MP + MS, NB = 40;
constexpr int LDP0 = 3072, LDP1 = 3584;
constexpr float EPS = 1e-6f, LOG2E = 1.4426950408889634f;
constexpr float QSCALE_B = 0.10206207261596577f * LOG2E;
constexpr float QSCALE_D = 0.125f * LOG2E;
constexpr int LDS_BYTES = 147456;
#ifndef REP_PREP
#define REP_PREP 1
#endif
#ifndef REP_PRE0
#define REP_PRE0 1
#endif
#ifndef REP_GMLP
#define REP_GMLP 1
#endif
#ifndef REP_MERGE
#define REP_MERGE 1
#endif
#ifndef REP_BAR
#define REP_BAR 1
#endif
#ifndef REP_ATTN
#define REP_ATTN 1
#endif
#ifndef REP_DIL
#define REP_DIL 1
#endif
#ifndef REP_GEMM
#define REP_GEMM 1
#endif

constexpr size_t MiB = 1u << 20;
constexpr size_t WS_CTL = 0;
constexpr size_t WS_MOD = 1 * MiB;
constexpr size_t WS_WINE = 2 * MiB;
constexpr size_t WS_WINO = 8 * MiB;
constexpr size_t WS_WOE = 15 * MiB;
constexpr size_t WS_WOO = 17 * MiB;
constexpr size_t WS_WUQ = 19 * MiB;
constexpr size_t WS_WUKV = 19 * MiB + 512 * 1024;
constexpr size_t WS_CWS = 20 * MiB;
constexpr size_t WS_BIAS = 20 * MiB + 256 * 1024;
constexpr size_t WS_LSE = 21 * MiB;
constexpr size_t WS_SW = 30 * MiB;
constexpr size_t WS_ROWSS = 31 * MiB;
constexpr size_t WS_H = 32 * MiB;
constexpr size_t WS_P = 224 * MiB;
constexpr size_t WS_V = 896 * MiB;
constexpr size_t WS_END = 992 * MiB;
constexpr size_t OUT_Q = 0, OUT_KV = 144 * MiB;

struct Params {
    const float *xp, *xs, *cp, *cs, *norm_g, *w_mod, *b_mod, *rel_bias, *w_in_e, *a_conv, *q_norm, *w_uq, *kv_norm, *w_ukv,
        *q_gain, *k_gain, *w_out_e, *w_in_o, *vn_g, *vn_b, *c_ws, *c_bs, *dq_gain, *dk_gain, *w_out_o;
    float* out; unsigned char* ws; unsigned long long pad;
};

__device__ __forceinline__ unsigned pk2(float lo, float hi) { unsigned r; asm volatile("v_cvt_pk_bf16_f32 %0, %1, %2" : "=v"(r) : "v"(lo), "v"(hi)); return r; }
__device__ __forceinline__ float bflo(unsigned w) { return __uint_as_float(w << 16); }
__device__ __forceinline__ float bfhi(unsigned w) { return __uint_as_float(w & 0xffff0000u); }
__device__ __forceinline__ float wave_sum(float v) {
#pragma unroll
    for (int o = 1; o < 64; o <<= 1) v += __shfl_xor(v, o);
    return v;
}
__device__ __forceinline__ float sum8(float v) { v += __shfl_xor(v, 1); v += __shfl_xor(v, 2); v += __shfl_xor(v, 4); return v; }
__device__ __forceinline__ float fexp2(float x) { return __builtin_amdgcn_exp2f(x); }
__device__ __forceinline__ float frcp(float x) { return __builtin_amdgcn_rcpf(x); }
__device__ __forceinline__ float silu(float x) { return x * frcp(1.f + fexp2(-x * LOG2E)); }
__device__ __forceinline__ float gelu_t(float x) { const float u = 0.7978845608028654f * (x + 0.044715f * x * x * x); return x * frcp(1.f + fexp2(-2.f * LOG2E * u)); }
__device__ __forceinline__ int crow(int r, int hi) { return (r & 3) + 8 * (r >> 2) + 4 * hi; }
__device__ __forceinline__ int bid_of(int m) { return m < MP ? (m >> 12) : 8 + ((m - MP) >> 11); }
__device__ __forceinline__ float swap_max(float x) { auto rr = __builtin_amdgcn_permlane32_swap(__float_as_uint(x), __float_as_uint(x), false, false); return fmaxf(__uint_as_float(rr[0]), __uint_as_float(rr[1])); }
__device__ __forceinline__ float swap_sum(float x) { auto rr = __builtin_amdgcn_permlane32_swap(__float_as_uint(x), __float_as_uint(x), false, false); return __uint_as_float(rr[0]) + __uint_as_float(rr[1]); }
__device__ __forceinline__ int opaque_tid() { int t = threadIdx.x; asm volatile("" : "+v"(t)); return t; }
#define LDS_WAIT() asm volatile("s_waitcnt lgkmcnt(0)" ::: "memory")
#define VM_WAIT() asm volatile("s_waitcnt vmcnt(0)" ::: "memory")
#define SBAR() __builtin_amdgcn_sched_barrier(0)
template <int OFF> __device__ __forceinline__ s16x4 tr_read(unsigned addr) { s16x4 r; asm volatile("ds_read_b64_tr_b16 %0, %1 offset:%2" : "=&v"(r) : "v"(addr), "i"(OFF) : "memory"); return r; }
#define PK8(L, H) (bf16x8){L[0], L[1], L[2], L[3], H[0], H[1], H[2], H[3]}

__device__ __forceinline__ void gbar1(unsigned* bar, unsigned& gen) {
    asm volatile("s_waitcnt vmcnt(0) lgkmcnt(0)" ::: "memory");
    __syncthreads();
    if (threadIdx.x == 0) {
        __builtin_amdgcn_fence(__ATOMIC_RELEASE, "agent");
        asm volatile("s_waitcnt vmcnt(0)" ::: "memory");
        const unsigned target = (gen + 1u) * gridDim.x;
        __hip_atomic_fetch_add(bar, 1u, __ATOMIC_RELAXED, __HIP_MEMORY_SCOPE_AGENT);
        unsigned spins = 0;
        while (__hip_atomic_load(bar, __ATOMIC_RELAXED, __HIP_MEMORY_SCOPE_AGENT) < target) { __builtin_amdgcn_s_sleep(2); if (++spins > (1u << 22)) break; }
        __builtin_amdgcn_fence(__ATOMIC_ACQUIRE, "agent");
        asm volatile("s_waitcnt vmcnt(0)" ::: "memory");
    }
    ++gen;
    __syncthreads();
}

__device__ __forceinline__ void gbar(unsigned* bar, unsigned& gen) { for (int r = 0; r < REP_BAR; ++r) gbar1(bar, gen); }

#define XB_TMO      128
#define XB_XCNT(j)  (256  + 64 * (j))
#define XB_XSUB(j)  (1280 + 64 * (j))
#define XB_XGEN(j)  (2304 + 64 * (j))
#define XB_TOP      3328
#define XB_TOPGEN   3392
#define XCD_BAR_WORDS 3456
#define XB_SPIN_CAP (1u << 22)
__device__ __forceinline__ unsigned xb_ld(unsigned* p)              { return __hip_atomic_load(p, __ATOMIC_RELAXED, __HIP_MEMORY_SCOPE_AGENT); }
__device__ __forceinline__ unsigned xb_add(unsigned* p, unsigned v) { return __hip_atomic_fetch_add(p, v, __ATOMIC_RELAXED, __HIP_MEMORY_SCOPE_AGENT); }
__device__ __forceinline__ unsigned xb_xcc_id() { return (unsigned)__builtin_amdgcn_s_getreg((3 << 11) | 20) & 0xFu; }
#define XB_SPIN(cond, bar) do { unsigned _sp = 0; while (cond) { __builtin_amdgcn_s_sleep(1); \
    if ((++_sp & 255u) == 0u) { if (xb_ld(&(bar)[XB_TMO])) break; if (_sp > XB_SPIN_CAP) { atomicAdd(&(bar)[XB_TMO], 1u); break; } } } } while (0)
struct XcdBarrier { unsigned* bar; unsigned x; volatile LAS unsigned* st; };
__device__ __forceinline__ XcdBarrier xcd_barrier_post(unsigned* bar, volatile LAS unsigned* st) {
    XcdBarrier b; b.bar = bar; b.x = xb_xcc_id(); b.st = st;
    if (threadIdx.x == 0) (void)xb_add(&bar[XB_XCNT(b.x)], 1u);
    return b;
}
__device__ __forceinline__ void xcd_barrier_complete(unsigned* bar, unsigned x, unsigned& nloc, unsigned& nx) {
    const unsigned G = gridDim.x * gridDim.y * gridDim.z;
    unsigned sum, cnt, mine, sp = 0u;
    for (;;) {
        sum = 0u; cnt = 0u; mine = 0u;
#pragma unroll
        for (unsigned j = 0; j < 16; ++j) { const unsigned c = xb_ld(&bar[XB_XCNT(j)]); sum += c; cnt += (c > 0u) ? 1u : 0u; mine = (j == x) ? c : mine; }
        if (sum == G) break;
        __builtin_amdgcn_s_sleep(1);
        if ((++sp & 255u) == 0u) { if (xb_ld(&bar[XB_TMO])) break; if (sp > XB_SPIN_CAP) { atomicAdd(&bar[XB_TMO], 1u); break; } }
    }
    nloc = mine > 0u ? mine : 1u; nx = cnt > 0u ? cnt : 1u;
}
__device__ __forceinline__ void xcd_barrier(const XcdBarrier& b) {
    asm volatile("s_waitcnt vmcnt(0)" ::: "memory");
    __syncthreads();
    if (threadIdx.x == 0) {
        unsigned* bar = b.bar;
        __builtin_amdgcn_s_waitcnt(0);
        unsigned nloc = b.st[0], nx = b.st[1];
        if (nloc == 0u) { xcd_barrier_complete(bar, b.x, nloc, nx); b.st[0] = nloc; b.st[1] = nx; }
        const unsigned old = xb_add(&bar[XB_XSUB(b.x)], 1u);
        const unsigned gen = old / nloc;
        if (old + 1u == (gen + 1u) * nloc) {
            __builtin_amdgcn_fence(__ATOMIC_RELEASE, "agent");
            asm volatile("s_waitcnt vmcnt(0)" ::: "memory");
            const unsigned og = xb_add(&bar[XB_TOP], 1u);
            const unsigned tg = og / nx;
            if (og + 1u == (tg + 1u) * nx) xb_add(&bar[XB_TOPGEN], 1u);
            else XB_SPIN(xb_ld(&bar[XB_TOPGEN]) == tg, bar);
            __builtin_amdgcn_fence(__ATOMIC_ACQUIRE, "agent");
            xb_add(&bar[XB_XGEN(b.x)], 1u);
            asm volatile("s_waitcnt vmcnt(0)" ::: "memory");
        } else {
            XB_SPIN(xb_ld(&bar[XB_XGEN(b.x)]) == gen, bar);
            __builtin_amdgcn_fence(__ATOMIC_ACQUIRE, "agent");
            asm volatile("s_waitcnt vmcnt(0)" ::: "memory");
        }
    }
    __syncthreads();
}
namespace pg8 {
constexpr int BM = 256, BK = 64, HALF = 128, HTB = HALF * BK * 2, STAGE_BYTES = 8 * HTB, NXCD = 8, WGM = 8;
__device__ __forceinline__ int lds_byte(int r, int c) { const int st = (r >> 4) * 2 + (c >> 5), rr = r & 15, cc = c & 31, ob = rr * 64 + cc * 2; return st * 1024 + (ob ^ (((ob >> 9) & 1) << 5)); }
__device__ __forceinline__ void stage_rc(int b, int& R, int& C) { const int st = b / 1024, sb = b % 1024, swz = sb ^ (((sb >> 9) & 1) << 5); R = (st >> 1) * 16 + swz / 64; C = (st & 1) * 32 + (swz % 64) / 2; }
__device__ __forceinline__ int perm32(int rho) { const int n = rho >> 4, i = rho & 15; return 8 * (i >> 2) + 4 * n + (i & 3); }
struct Unit { int pm, pn; };
struct Gemm { const bf16_t* A; const bf16_t* Bt; int M, N, K, lda; int kjt, kjb; };
struct StaticOrder {
    int nM, nN, nwg, G, c;
    __device__ void init(int M_, int N_, int G_, int c_) { nM = M_ / BM; nN = N_ / BM; nwg = nM * nN; G = G_; c = c_; }
    __device__ bool next(int i, Unit& u) const {
        const long L = (long)i * G + c; if (L >= nwg) return false;
        int wgid = (int)L; { const int q = nwg / NXCD, r = nwg % NXCD, xcd = wgid % NXCD, off = wgid / NXCD; wgid = (xcd < r ? xcd * (q + 1) : r * (q + 1) + (xcd - r) * q) + off; }
        const int nig = WGM * nN, gid = wgid / nig, fm = gid * WGM, gsz = (nM - fm) < WGM ? (nM - fm) : WGM;
        u.pm = fm + ((wgid % nig) % gsz); u.pn = (wgid % nig) / gsz; return true;
    }
};
struct EpiBf16 {
    bf16_t* O; int ldc;
    __device__ __forceinline__ void operator()(const f32x4 (&acc)[2][2][4][2], const Unit& u, int wr, int wc, int fr, int fq) const {
        const int row0 = u.pm * BM + wr * 64 + fr, col0 = u.pn * BM + wc * 32 + 8 * fq;
#pragma unroll
        for (int ai = 0; ai < 2; ++ai)
#pragma unroll
            for (int m = 0; m < 4; ++m) { bf16_t* rowp = O + (size_t)(row0 + ai * HALF + m * 16) * ldc + col0;
#pragma unroll
                for (int bj = 0; bj < 2; ++bj) { const f32x4 v0 = acc[ai][bj][m][0], v1 = acc[ai][bj][m][1];
                    u32x4 w; w.x = pk2(v0[0], v0[1]); w.y = pk2(v0[2], v0[3]); w.z = pk2(v1[0], v1[1]); w.w = pk2(v1[2], v1[3]);
                    *(u32x4*)(rowp + bj * HALF) = w; } }
    }
};
struct EpiResid {
    const float* bp; const float* bs; float* out; const float* gate;
    __device__ __forceinline__ void operator()(const f32x4 (&acc)[2][2][4][2], const Unit& u, int wr, int wc, int fr, int fq) const {
        const int row0 = u.pm * BM + wr * 64 + fr, col0 = u.pn * BM + wc * 32 + 8 * fq;
        const int bid = bid_of(u.pm * BM);
        const float* gp = gate + (size_t)bid * 3072 + col0;
        f32x4 g[2][2];
#pragma unroll
        for (int bj = 0; bj < 2; ++bj) { g[bj][0] = *(const f32x4*)(gp + bj * HALF); g[bj][1] = *(const f32x4*)(gp + bj * HALF + 4); }
#pragma unroll
        for (int ai = 0; ai < 2; ++ai)
#pragma unroll
            for (int m = 0; m < 4; ++m) { const int row = row0 + ai * HALF + m * 16;
                const float* bptr = (row < MP ? bp + (size_t)row * D : bs + (size_t)(row - MP) * D) + col0; float* optr = out + (size_t)row * D + col0;
#pragma unroll
                for (int bj = 0; bj < 2; ++bj) {
                    const f32x4 b0 = *(const f32x4*)(bptr + bj * HALF), b1 = *(const f32x4*)(bptr + bj * HALF + 4);
                    *(f32x4*)(optr + bj * HALF) = b0 + g[bj][0] * acc[ai][bj][m][0]; *(f32x4*)(optr + bj * HALF + 4) = b1 + g[bj][1] * acc[ai][bj][m][1]; } }
    }
};

struct EpiResid0 {
    const float* bp; const float* bs; float* out; const float* mod0; const float* mod1; const float* ng1; bf16_t* Hx; float* rowss;
    __device__ __forceinline__ void operator()(const f32x4 (&acc)[2][2][4][2], const Unit& u, int wr, int wc, int fr, int fq) const {
        const int row0 = u.pm * BM + wr * 64 + fr, col0 = u.pn * BM + wc * 32 + 8 * fq;
        const int bid = bid_of(u.pm * BM);
        const float* gp = mod0 + (size_t)bid * 3072 + 2048 + col0;
        const float* sp = mod1 + (size_t)bid * 3072 + 1024 + col0;
        f32x4 g[2][2], gv[2][2];
#pragma unroll
        for (int bj = 0; bj < 2; ++bj)
#pragma unroll
            for (int n = 0; n < 2; ++n) { g[bj][n] = *(const f32x4*)(gp + bj * HALF + 4 * n);
                gv[bj][n] = *(const f32x4*)(ng1 + col0 + bj * HALF + 4 * n) * (*(const f32x4*)(sp + bj * HALF + 4 * n) + 1.f); }
#pragma unroll
        for (int ai = 0; ai < 2; ++ai)
#pragma unroll
            for (int m = 0; m < 4; ++m) { const int row = row0 + ai * HALF + m * 16;
                const float* bptr = (row < MP ? bp + (size_t)row * D : bs + (size_t)(row - MP) * D) + col0; float* optr = out + (size_t)row * D + col0;
                bf16_t* hptr = Hx + (size_t)row * D + col0;
                float ss = 0.f;
#pragma unroll
                for (int bj = 0; bj < 2; ++bj) {
                    const f32x4 o0 = *(const f32x4*)(bptr + bj * HALF) + g[bj][0] * acc[ai][bj][m][0], o1 = *(const f32x4*)(bptr + bj * HALF + 4) + g[bj][1] * acc[ai][bj][m][1];
                    *(f32x4*)(optr + bj * HALF) = o0; *(f32x4*)(optr + bj * HALF + 4) = o1;
                    ss += (o0[0] * o0[0] + o0[1] * o0[1]) + (o0[2] * o0[2] + o0[3] * o0[3]) + (o1[0] * o1[0] + o1[1] * o1[1]) + (o1[2] * o1[2] + o1[3] * o1[3]);
                    const f32x4 h0 = o0 * gv[bj][0], h1 = o1 * gv[bj][1];
                    u32x4 w; w.x = pk2(h0[0], h0[1]); w.y = pk2(h0[2], h0[3]); w.z = pk2(h1[0], h1[1]); w.w = pk2(h1[2], h1[3]);
                    *(u32x4*)(hptr + bj * HALF) = w; }
                ss += __shfl_xor(ss, 16); ss += __shfl_xor(ss, 32);
                if (fq == 0) atomicAdd(rowss + row, ss); }
    }
};
struct EpiInO {
    bf16_t* O; const float* qgain; const float* kgain; const float* rowss; const float* sW;
    __device__ __forceinline__ void operator()(const f32x4 (&acc)[2][2][4][2], const Unit& u, int wr, int wc, int fr, int fq) const {
        constexpr int ldc = LDP1;
        const int row0 = u.pm * BM + wr * 64 + fr;
        const float* swb = sW + (size_t)bid_of(u.pm * BM) * LDP1;
        if (u.pn >= 6 && u.pn < 10) {
            const bool isq = u.pn < 8; const int sect = isq ? 1536 : 2048; const int hl = (u.pn - (isq ? 6 : 8)) * 4 + wc;
            const float* gp = (isq ? qgain : kgain) + 8 * fq; const float sc = isq ? QSCALE_D : 1.f;
            const int lcol = sect + hl * 64 + 8 * fq;
            f32x4 g[2][2], sw[2][2];
#pragma unroll
            for (int bj = 0; bj < 2; ++bj) { g[bj][0] = *(const f32x4*)(gp + 32 * bj) * sc; g[bj][1] = *(const f32x4*)(gp + 32 * bj + 4) * sc;
                sw[bj][0] = *(const f32x4*)(swb + lcol + 32 * bj); sw[bj][1] = *(const f32x4*)(swb + lcol + 32 * bj + 4); }
#pragma unroll
            for (int ai = 0; ai < 2; ++ai)
#pragma unroll
                for (int m = 0; m < 4; ++m) {
                    const int row = row0 + ai * HALF + m * 16;
                    const float rs = __builtin_amdgcn_rsqf(rowss[row] * (1.f / D) + EPS);
                    f32x4 v[2][2]; float ss = 0.f;
#pragma unroll
                    for (int bj = 0; bj < 2; ++bj)
#pragma unroll
                        for (int n = 0; n < 2; ++n) { v[bj][n] = acc[ai][bj][m][n] * rs + sw[bj][n]; ss += (v[bj][n][0] * v[bj][n][0] + v[bj][n][1] * v[bj][n][1]) + (v[bj][n][2] * v[bj][n][2] + v[bj][n][3] * v[bj][n][3]); }
                    ss += __shfl_xor(ss, 16); ss += __shfl_xor(ss, 32);
                    const float r = __builtin_amdgcn_rsqf(ss * (1.f / 64.f) + EPS);
                    bf16_t* rowp = O + (size_t)row * ldc + lcol;
#pragma unroll
                    for (int bj = 0; bj < 2; ++bj) { const f32x4 v0 = v[bj][0] * r * g[bj][0], v1 = v[bj][1] * r * g[bj][1];
                        u32x4 w; w.x = pk2(v0[0], v0[1]); w.y = pk2(v0[2], v0[3]); w.z = pk2(v1[0], v1[1]); w.w = pk2(v1[2], v1[3]);
                        *(u32x4*)(rowp + 32 * bj) = w; }
                }
        } else {
            const int col0 = u.pn * BM + wc * 32 + 8 * fq;
            f32x4 sw[2][2];
#pragma unroll
            for (int bj = 0; bj < 2; ++bj) { sw[bj][0] = *(const f32x4*)(swb + col0 + bj * HALF); sw[bj][1] = *(const f32x4*)(swb + col0 + bj * HALF + 4); }
#pragma unroll
            for (int ai = 0; ai < 2; ++ai)
#pragma unroll
                for (int m = 0; m < 4; ++m) { const int row = row0 + ai * HALF + m * 16;
                    const float rs = __builtin_amdgcn_rsqf(rowss[row] * (1.f / D) + EPS);
                    bf16_t* rowp = O + (size_t)row * ldc + col0;
#pragma unroll
                    for (int bj = 0; bj < 2; ++bj) { const f32x4 v0 = acc[ai][bj][m][0] * rs + sw[bj][0], v1 = acc[ai][bj][m][1] * rs + sw[bj][1];
                        u32x4 w; w.x = pk2(v0[0], v0[1]); w.y = pk2(v0[2], v0[3]); w.z = pk2(v1[0], v1[1]); w.w = pk2(v1[2], v1[3]);
                        *(u32x4*)(rowp + bj * HALF) = w; } }
        }
    }
};

struct EpiInE {
    bf16_t* O;
    __device__ __forceinline__ void operator()(const f32x4 (&acc)[2][2][4][2], const Unit& u, int wr, int wc, int fr, int fq) const {
        constexpr int ldc = LDP0;
        const int row0 = u.pm * BM + wr * 64 + fr;
        if (u.pn < 8) {
            const bool isbz = u.pn >= 4; const int cb = (isbz ? 512 : 0) + 128 * (u.pn & 3) + 16 * wc + 4 * fq;
#pragma unroll
            for (int ai = 0; ai < 2; ++ai)
#pragma unroll
                for (int m = 0; m < 4; ++m) { bf16_t* rowp = O + (size_t)(row0 + ai * HALF + m * 16) * ldc + cb;
#pragma unroll
                    for (int bj = 0; bj < 2; ++bj) { const f32x4 v0 = acc[ai][bj][m][0], v1 = acc[ai][bj][m][1];
                        f32x4 r;
                        if (isbz) { r[0] = v0[0] * silu(v1[0]); r[1] = v0[1] * silu(v1[1]); r[2] = v0[2] * silu(v1[2]); r[3] = v0[3] * silu(v1[3]); }
                        else r = v0 * v1;
                        u32x2 w; w.x = pk2(r[0], r[1]); w.y = pk2(r[2], r[3]);
                        *(u32x2*)(rowp + 64 * bj) = w; } }
        } else {
            const int col0 = u.pn * BM + wc * 32 + 8 * fq;
#pragma unroll
            for (int ai = 0; ai < 2; ++ai)
#pragma unroll
                for (int m = 0; m < 4; ++m) { bf16_t* rowp = O + (size_t)(row0 + ai * HALF + m * 16) * ldc + col0;
#pragma unroll
                    for (int bj = 0; bj < 2; ++bj) { const f32x4 v0 = acc[ai][bj][m][0], v1 = acc[ai][bj][m][1];
                        u32x4 w; w.x = pk2(v0[0], v0[1]); w.y = pk2(v0[2], v0[3]); w.z = pk2(v1[0], v1[1]); w.w = pk2(v1[2], v1[3]);
                        *(u32x4*)(rowp + bj * HALF) = w; } }
        }
    }
};

template <class Epi>
__device__ __forceinline__ void gemm_phase(LAS unsigned char* lds, const Gemm g, const StaticOrder& S, const Epi& E) {
    const int tid = opaque_tid(), wid = __builtin_amdgcn_readfirstlane(tid >> 6), lane = tid & 63, wr = wid >> 2, wc = wid & 3, fr = lane & 15, fq = lane >> 4;
    const int K = g.K, nt = K / BK, lda = g.lda;
    unsigned voffA[2], voffB[2];
#pragma unroll
    for (int i = 0; i < 2; ++i) { int R, C; stage_rc(tid * 16 + i * 8192, R, C); const int Rb = (R & ~31) + perm32(R & 31);
        voffA[i] = (unsigned)(R * lda + C) * 2u; voffB[i] = (unsigned)(Rb * K + C) * 2u; }
    const size_t kstep = (size_t)(BK * 2);
    const size_t hstepA = (size_t)HALF * lda * 2, hstepB = (size_t)HALF * K * 2;
    const size_t tstepA = 2 * hstepA, tstepB = 2 * hstepB;
    const unsigned ldsw = (unsigned)wid * 1024u;
    const int aoff = lds_byte(wr * 64 + fr, fq * 8), boff = lds_byte(wc * 32 + fr, fq * 8);
#define PG8_SA(b, h) (((b) * 2 + (h)) * HTB)
#define PG8_SB(b, h) ((4 + (b) * 2 + (h)) * HTB)
#define PG8_STAGE(bufoff, gbase, voff) do { _Pragma("unroll") for (int _i = 0; _i < 2; ++_i) \
        __builtin_amdgcn_global_load_lds((const unsigned*)((const char*)(gbase) + (voff)[_i]), (LAS unsigned*)(lds + (bufoff) + ldsw + _i * 8192), 16, 0, 0); } while (0)
#define PG8_LDA(dst, b, h) do { _Pragma("unroll") for (int m = 0; m < 4; ++m) _Pragma("unroll") for (int k = 0; k < 2; ++k) dst[m][k] = *(const LAS bf16x8*)(lds + PG8_SA(b, h) + aoff + m * 2048 + k * 1024); } while (0)
#define PG8_LDB(dst, b, h) do { _Pragma("unroll") for (int n = 0; n < 2; ++n) _Pragma("unroll") for (int k = 0; k < 2; ++k) dst[n][k] = *(const LAS bf16x8*)(lds + PG8_SB(b, h) + boff + n * 2048 + k * 1024); } while (0)
#define PG8_MMA(ai, bj, At, Bt) do { __builtin_amdgcn_s_setprio(1); _Pragma("unroll") for (int m = 0; m < 4; ++m) _Pragma("unroll") for (int n = 0; n < 2; ++n) _Pragma("unroll") for (int k = 0; k < 2; ++k) \
        acc[ai][bj][m][n] = __builtin_amdgcn_mfma_f32_16x16x32_bf16(Bt[n][k], At[m][k], acc[ai][bj][m][n], 0, 0, 0); __builtin_amdgcn_s_setprio(0); } while (0)
#define PG8_WAIT_V(n) asm volatile("s_waitcnt vmcnt(" #n ")" ::: "memory")
#define PG8_WAIT_L(n) asm volatile("s_waitcnt lgkmcnt(" #n ")" ::: "memory")
#define PG8_BAR __builtin_amdgcn_s_barrier()
#define PG8_SCHED __builtin_amdgcn_sched_barrier(0)
    Unit cur, nxt; int ui = 0;
    if (!S.next(0, cur)) return;
    f32x4 acc[2][2][4][2];
#pragma unroll
    for (int a = 0; a < 2; ++a)
#pragma unroll
        for (int b = 0; b < 2; ++b)
#pragma unroll
            for (int m = 0; m < 4; ++m)
#pragma unroll
                for (int n = 0; n < 2; ++n) acc[a][b][m][n] = (f32x4){0.f, 0.f, 0.f, 0.f};
    bf16x8 At[4][2], B0[2][2], B1[2][2];
    const char* cA = (const char*)g.A + (size_t)cur.pm * tstepA; const char* cB = (const char*)g.Bt + (size_t)cur.pn * tstepB;
    PG8_STAGE(PG8_SB(0, 0), cB, voffB); PG8_STAGE(PG8_SB(0, 1), cB + hstepB, voffB); PG8_STAGE(PG8_SA(0, 0), cA, voffA); PG8_STAGE(PG8_SA(0, 1), cA + hstepA, voffA);
    if (wr == 1) PG8_BAR;
    PG8_WAIT_V(2); PG8_BAR;
    PG8_STAGE(PG8_SB(1, 0), cB + kstep, voffB); PG8_STAGE(PG8_SA(1, 0), cA + kstep, voffA); PG8_STAGE(PG8_SB(1, 1), cB + hstepB + kstep, voffB);
    PG8_WAIT_V(6); PG8_BAR;
    for (;;) {
        const bool has_next = S.next(ui + 1, nxt);
        const char* nA = has_next ? (const char*)g.A + (size_t)nxt.pm * tstepA : cA; const char* nB = has_next ? (const char*)g.Bt + (size_t)nxt.pn * tstepB : cB;
        for (int t = 0; t < nt; t += 2) {
            const bool last = (t == nt - 2);
            const char* a1 = cA + (size_t)(t + 1) * kstep + ((t + 1) >= g.kjt ? g.kjb : 0);
            const char* a2 = last ? nA : cA + (size_t)(t + 2) * kstep + ((t + 2) >= g.kjt ? g.kjb : 0); const char* b2 = last ? nB : cB + (size_t)(t + 2) * kstep;
            const char* a3 = last ? nA + kstep : cA + (size_t)(t + 3) * kstep + ((t + 3) >= g.kjt ? g.kjb : 0); const char* b3 = b2 + kstep;
            PG8_LDB(B0, 0, 0); PG8_LDB(B1, 0, 1); PG8_SCHED; PG8_LDA(At, 0, 0); PG8_STAGE(PG8_SA(1, 1), a1 + hstepA, voffA);
            PG8_WAIT_V(8); PG8_WAIT_L(0); PG8_BAR; PG8_MMA(0, 0, At, B0); PG8_MMA(0, 1, At, B1); PG8_BAR; PG8_SCHED;
            PG8_LDA(At, 0, 1); PG8_STAGE(PG8_SB(0, 0), b2, voffB); PG8_STAGE(PG8_SB(0, 1), b2 + hstepB, voffB); PG8_STAGE(PG8_SA(0, 0), a2, voffA);
            PG8_WAIT_V(8); PG8_WAIT_L(0); PG8_BAR; PG8_MMA(1, 0, At, B0); PG8_MMA(1, 1, At, B1); PG8_BAR; PG8_SCHED;
            PG8_LDB(B0, 1, 0); PG8_LDB(B1, 1, 1); PG8_SCHED; PG8_LDA(At, 1, 0); PG8_STAGE(PG8_SA(0, 1), a2 + hstepA, voffA);
            PG8_WAIT_V(8); PG8_WAIT_L(0); PG8_BAR; PG8_MMA(0, 0, At, B0); PG8_MMA(0, 1, At, B1); PG8_BAR; PG8_SCHED;
            PG8_LDA(At, 1, 1); PG8_STAGE(PG8_SB(1, 0), b3, voffB); PG8_STAGE(PG8_SB(1, 1), b3 + hstepB, voffB); PG8_STAGE(PG8_SA(1, 0), a3, voffA);
            PG8_WAIT_V(8); PG8_WAIT_L(0); PG8_BAR; PG8_MMA(1, 0, At, B0); PG8_MMA(1, 1, At, B1); PG8_BAR; PG8_SCHED;
        }
        if (wr == 0) PG8_BAR;
        E(acc, cur, wr, wc, fr, fq);
        if (!has_next) break;
#pragma unroll
        for (int a = 0; a < 2; ++a)
#pragma unroll
            for (int b = 0; b < 2; ++b)
#pragma unroll
                for (int m = 0; m < 4; ++m)
#pragma unroll
                    for (int n = 0; n < 2; ++n) acc[a][b][m][n] = (f32x4){0.f, 0.f, 0.f, 0.f};
        cur = nxt; cA = nA; cB = nB; ++ui;
        if (wr == 1) PG8_BAR;
    }
    PG8_WAIT_V(0);
    PG8_BAR;
#undef PG8_SA
#undef PG8_SB
#undef PG8_STAGE
#undef PG8_LDA
#undef PG8_LDB
#undef PG8_MMA
#undef PG8_WAIT_V
#undef PG8_WAIT_L
#undef PG8_BAR
#undef PG8_SCHED
}
}

__device__ __forceinline__ void transpose_item(const float* W, int N, int k0, int n0, bf16_t* WT, int ldo, const float* kscale, LAS float* scr, int lane) {
#pragma unroll 8
    for (int i = 0; i < 32; ++i) { const int kk = 2 * i + (lane >> 5); float v = W[(size_t)(k0 + kk) * N + n0 + (lane & 31)]; if (kscale) v *= kscale[k0 + kk]; scr[kk * 33 + (lane & 31)] = v; }
    LDS_WAIT();
    const int c = lane & 7;
#pragma unroll
    for (int j = 0; j < 4; ++j) { const int n = (lane >> 3) + 8 * j; const LAS float* s = scr + (8 * c) * 33 + n;
        u32x4 o; o.x = pk2(s[0 * 33], s[1 * 33]); o.y = pk2(s[2 * 33], s[3 * 33]); o.z = pk2(s[4 * 33], s[5 * 33]); o.w = pk2(s[6 * 33], s[7 * 33]);
        *(u32x4*)(WT + (size_t)(n0 + n) * ldo + k0 + 8 * c) = o; }
    LDS_WAIT();
}

__device__ __forceinline__ void transpose_item2(const float* W, int N, int k0, int n0, int nd0, bf16_t* WT, int ldo, LAS float* scr, int lane) {
#pragma unroll 8
    for (int i = 0; i < 32; ++i) { const int kk = 2 * i + (lane >> 5); scr[kk * 33 + (lane & 31)] = W[(size_t)(k0 + kk) * N + n0 + (lane & 31)]; }
    LDS_WAIT();
    const int c = lane & 7;
#pragma unroll
    for (int j = 0; j < 4; ++j) { const int n = (lane >> 3) + 8 * j; const LAS float* sp = scr + (8 * c) * 33 + n;
        u32x4 o; o.x = pk2(sp[0 * 33], sp[1 * 33]); o.y = pk2(sp[2 * 33], sp[3 * 33]); o.z = pk2(sp[4 * 33], sp[5 * 33]); o.w = pk2(sp[6 * 33], sp[7 * 33]);
        *(u32x4*)(WT + (size_t)(nd0 + n) * ldo + k0 + 8 * c) = o; }
    LDS_WAIT();
}

__device__ __forceinline__ int phys_pair(int ch, int n) { return 256 * (ch >> 7) + 128 * ((ch >> 6) & 1) + 32 * ((ch >> 4) & 3) + 8 * ((ch >> 2) & 3) + 4 * n + (ch & 3); }
__device__ __forceinline__ int map_ine(int col) {
    if (col < 512) return 1024 + phys_pair(col, 0);
    if (col < 1024) return phys_pair(col - 512, 0);
    if (col < 1536) return phys_pair(col - 1024, 1);
    if (col < 2048) return 1024 + phys_pair(col - 1536, 1);
    return col;
}
__device__ __forceinline__ void transpose_item_ine(const float* W, int N, int k0, int n0, bf16_t* WT, int ldo, LAS float* scr, int lane) {
#pragma unroll 8
    for (int i = 0; i < 32; ++i) { const int kk = 2 * i + (lane >> 5); scr[kk * 33 + (lane & 31)] = W[(size_t)(k0 + kk) * N + n0 + (lane & 31)]; }
    LDS_WAIT();
    const int c = lane & 7;
#pragma unroll
    for (int j = 0; j < 4; ++j) { const int n = (lane >> 3) + 8 * j; const LAS float* sp = scr + (8 * c) * 33 + n;
        u32x4 o; o.x = pk2(sp[0 * 33], sp[1 * 33]); o.y = pk2(sp[2 * 33], sp[3 * 33]); o.z = pk2(sp[4 * 33], sp[5 * 33]); o.w = pk2(sp[6 * 33], sp[7 * 33]);
        *(u32x4*)(WT + (size_t)map_ine(n0 + n) * ldo + k0 + 8 * c) = o; }
    LDS_WAIT();
}

__device__ __forceinline__ void p0_prep(const Params& p, LAS unsigned char* lds, int vcu, int G) {
    const int tid = opaque_tid(), lane = tid & 63, wave = tid >> 6;
    unsigned char* ws = p.ws;
    if (vcu < 192) {
        const int l = vcu / 96, j0 = (vcu % 96) * 32, col = tid & 31, ks = tid >> 5;
        LAS float* sl = (LAS float*)lds;
        LAS float* red = (LAS float*)(lds + 81920);
        float* mod = (float*)(ws + WS_MOD);
        const float* wp = p.w_mod + ((size_t)l * D + ks * 64) * 3072 + j0 + col;
        for (int half = 0; half < 2; ++half) {
            __syncthreads();
            for (int idx = tid; idx < 20 * 1024; idx += 512) { const int b = half * 20 + (idx >> 10), kk = idx & 1023;
                const float c = (b < 8) ? p.cp[b * D + kk] : p.cs[(b - 8) * D + kk]; sl[idx] = silu(c); }
            __syncthreads();
            float acc[20];
#pragma unroll
            for (int b = 0; b < 20; ++b) acc[b] = 0.f;
#pragma unroll 4
            for (int k4 = 0; k4 < 16; ++k4) {
                const float w0 = wp[(size_t)(k4 * 4 + 0) * 3072], w1 = wp[(size_t)(k4 * 4 + 1) * 3072], w2 = wp[(size_t)(k4 * 4 + 2) * 3072], w3 = wp[(size_t)(k4 * 4 + 3) * 3072];
#pragma unroll
                for (int b = 0; b < 20; ++b) { const f32x4 sv = *(const LAS f32x4*)(sl + b * 1024 + ks * 64 + k4 * 4); acc[b] += (sv.x * w0 + sv.y * w1) + (sv.z * w2 + sv.w * w3); }
            }
#pragma unroll
            for (int b = 0; b < 20; ++b) red[(ks * 20 + b) * 32 + col] = acc[b];
            __syncthreads();
            for (int o = tid; o < 640; o += 512) { const int b = o >> 5, c = o & 31; float sum = 0.f;
#pragma unroll
                for (int k = 0; k < 16; ++k) sum += red[(k * 20 + b) * 32 + c];
                mod[((size_t)l * NB + half * 20 + b) * 3072 + j0 + c] = sum + p.b_mod[l * 3072 + j0 + c]; }
        }
        __syncthreads();
    }
    LAS float* scr = (LAS float*)(lds + wave * 16384);
    const int gw = vcu * 8 + wave, NGW = G * 8;
    constexpr int I_INE = 16 * 93, I_INO = 16 * 112, I_OUT = 16 * 32, I_UQ = 4 * 24, I_UKV = 2 * 32;
    constexpr int NITEMS = I_INE + I_INO + 2 * I_OUT + I_UQ + I_UKV;
    for (int it = gw; it < NITEMS; it += NGW) {
        int r = it;
        if (r < I_INE) { transpose_item_ine(p.w_in_e, 2976, (r / 93) * 64, (r % 93) * 32, (bf16_t*)(ws + WS_WINE), 1024, scr, lane); continue; } r -= I_INE;
        if (r < I_INO) { const int nl = (r % 112) * 32; int nphys = nl;
            if (nl >= 1536 && nl < 2560) { const int sb = nl < 2048 ? 1536 : 2048, loc = nl - sb, hl = loc >> 6, d32 = (loc & 63) >> 5; nphys = sb + (hl >> 2) * 256 + d32 * 128 + (hl & 3) * 32; }
            transpose_item2(p.w_in_o, 3584, (r / 112) * 64, nl, nphys, (bf16_t*)(ws + WS_WINO), 1024, scr, lane); continue; } r -= I_INO;
        if (r < I_OUT) { transpose_item(p.w_out_e, 1024, (r / 32) * 64, (r % 32) * 32, (bf16_t*)(ws + WS_WOE), 1024, nullptr, scr, lane); continue; } r -= I_OUT;
        if (r < I_OUT) { transpose_item(p.w_out_o, 1024, (r / 32) * 64, (r % 32) * 32, (bf16_t*)(ws + WS_WOO), 1024, nullptr, scr, lane); continue; } r -= I_OUT;
        if (r < I_UQ) { transpose_item(p.w_uq, 768, (r / 24) * 64, (r % 24) * 32, (bf16_t*)(ws + WS_WUQ), 256, p.q_norm, scr, lane); continue; } r -= I_UQ;
        transpose_item(p.w_ukv, 1024, (r / 32) * 64, (r % 32) * 32, (bf16_t*)(ws + WS_WUKV), 128, p.kv_norm, scr, lane);
    }
    const long gt = (long)vcu * 512 + tid, GT = (long)G * 512;
    { unsigned* z = (unsigned*)(ws + WS_WINE + (size_t)2976 * 1024 * 2); for (long i = gt; i < 96 * 1024 / 2; i += GT) z[i] = 0u; }
    { float* z = (float*)(ws + WS_ROWSS); for (long i = gt; i < M; i += GT) z[i] = 0.f; }
    { unsigned* o = (unsigned*)(ws + WS_CWS); for (long i = gt; i < 4 * 128 * 128 / 2; i += GT) o[i] = pk2(p.c_ws[2 * i], p.c_ws[2 * i + 1]); }
    { float* bt = (float*)(ws + WS_BIAS);
      for (long i = gt; i < 3 * 8 * 129; i += GT) { const int g = (int)i / (8 * 129), h = ((int)i / 129) % 8, j = (int)i % 129 - 64;
          const int d = g == 0 ? 1 : (g == 1 ? 4 : 16), rel = d * j, n = rel < 0 ? -rel : rel;
          int v = n; if (n >= 8) { v = 8 + (n >= 15) + (n >= 27) + (n >= 50) + (n >= 91) + (n >= 166) + (n >= 305) + (n >= 559); }
          const int bucket = (rel > 0 ? 16 : 0) + v; bt[i] = p.rel_bias[bucket * 8 + h] * LOG2E; } }
}

__device__ __forceinline__ void sw1_phase(const Params& p, LAS unsigned char* lds, int vcu) {
    const int tid = opaque_tid();
    if (vcu < 112) {
        const int j0 = vcu * 32, col = tid & 31, ks = tid >> 5;
        LAS float* sl = (LAS float*)lds; LAS float* red = (LAS float*)(lds + 81920);
        const float* mod1 = (const float*)(p.ws + WS_MOD) + (size_t)NB * 3072;
        float* sw = (float*)(p.ws + WS_SW);
        const float* wp = p.w_in_o + ((size_t)ks * 64) * LDP1 + j0 + col;
        for (int half = 0; half < 2; ++half) {
            __syncthreads();
            for (int idx = tid; idx < 20 * 1024; idx += 512) { const int b = half * 20 + (idx >> 10), kk = idx & 1023; sl[idx] = mod1[(size_t)b * 3072 + kk]; }
            __syncthreads();
            float acc[20];
#pragma unroll
            for (int b = 0; b < 20; ++b) acc[b] = 0.f;
#pragma unroll 4
            for (int k4 = 0; k4 < 16; ++k4) {
                const float w0 = wp[(size_t)(k4 * 4 + 0) * LDP1], w1 = wp[(size_t)(k4 * 4 + 1) * LDP1], w2 = wp[(size_t)(k4 * 4 + 2) * LDP1], w3 = wp[(size_t)(k4 * 4 + 3) * LDP1];
#pragma unroll
                for (int b = 0; b < 20; ++b) { const f32x4 sv = *(const LAS f32x4*)(sl + b * 1024 + ks * 64 + k4 * 4); acc[b] += (sv.x * w0 + sv.y * w1) + (sv.z * w2 + sv.w * w3); }
            }
#pragma unroll
            for (int b = 0; b < 20; ++b) red[(ks * 20 + b) * 32 + col] = acc[b];
            __syncthreads();
            for (int o = tid; o < 640; o += 512) { const int b = o >> 5, c = o & 31; float sum = 0.f;
#pragma unroll
                for (int k = 0; k < 16; ++k) sum += red[(k * 20 + b) * 32 + c];
                sw[(size_t)(half * 20 + b) * LDP1 + j0 + c] = sum; }
        }
        __syncthreads();
    }
}

__device__ __forceinline__ void prenorm_phase(const Params& p, int layer, int vcu, int G) {
    const int tid = opaque_tid(), lane = tid & 63, wave = tid >> 6;
    const int gw = vcu * 8 + wave, NGW = G * 8;
    const float* mod = (const float*)(p.ws + WS_MOD) + (size_t)layer * NB * 3072;
    const float* ng = p.norm_g + layer * D;
    bf16_t* H = (bf16_t*)(p.ws + WS_H);
    for (int m0 = gw; m0 < M; m0 += 2 * NGW) {
        f32x4 v[2][4]; float s[2] = {0.f, 0.f};
#pragma unroll
        for (int u = 0; u < 2; ++u) { const int m = m0 + u * NGW; if (m < M) {
            const float* xr = layer == 0 ? (m < MP ? p.xp + (size_t)m * D : p.xs + (size_t)(m - MP) * D) : p.out + (size_t)m * D;
            const f32x4* x4 = (const f32x4*)xr + lane;
#pragma unroll
            for (int j = 0; j < 4; ++j) v[u][j] = x4[64 * j]; } }
#pragma unroll
        for (int u = 0; u < 2; ++u) { const int m = m0 + u * NGW; if (m < M) {
#pragma unroll
            for (int j = 0; j < 4; ++j) s[u] += (v[u][j].x * v[u][j].x + v[u][j].y * v[u][j].y) + (v[u][j].z * v[u][j].z + v[u][j].w * v[u][j].w);
            const float rstd = __builtin_amdgcn_rsqf(wave_sum(s[u]) * (1.f / D) + EPS);
            const float* mb = mod + (size_t)bid_of(m) * 3072;
#pragma unroll
            for (int j = 0; j < 4; ++j) { const int col = 4 * (lane + 64 * j);
                const f32x4 g4 = *(const f32x4*)(ng + col), sh = *(const f32x4*)(mb + col), sc = *(const f32x4*)(mb + 1024 + col);
                const f32x4 hh = v[u][j] * rstd * g4 * (sc + 1.f) + sh;
                u32x2 o; o.x = pk2(hh.x, hh.y); o.y = pk2(hh.z, hh.w);
                *(u32x2*)(H + (size_t)m * D + col) = o; } } }
    }
}

struct MlaTok { u32x2 cq; unsigned ckv, kra, krb, qa, qb; u32x4 q8, k8, v8, bz, cx0, cx1, cx2; };
__device__ __forceinline__ void mla_prep_phase(const Params& p, int vcu, int G) {
    const int tid = opaque_tid(), lane = tid & 63, wave = tid >> 6, h = lane >> 3, j = lane & 7;
    const int gw = vcu * 8 + wave, NGW = G * 8;
    const bf16_t* P0 = (const bf16_t*)(p.ws + WS_P);
    bf16_t* QU = (bf16_t*)((unsigned char*)p.out + OUT_Q);
    bf16_t* KV = (bf16_t*)((unsigned char*)p.out + OUT_KV);
    bf16_t* Vb = (bf16_t*)(p.ws + WS_V);
    bf16_t* YC = (bf16_t*)(p.ws + WS_H);
    float qg[12], kg[12];
#pragma unroll
    for (int i = 0; i < 8; ++i) { qg[i] = p.q_gain[8 * j + i]; kg[i] = p.k_gain[8 * j + i]; }
#pragma unroll
    for (int i = 0; i < 2; ++i) { qg[8 + i] = p.q_gain[64 + 2 * j + i]; qg[10 + i] = p.q_gain[80 + 2 * j + i]; kg[8 + i] = p.k_gain[64 + 2 * j + i]; kg[10 + i] = p.k_gain[80 + 2 * j + i]; }
    float inv[2];
#pragma unroll
    for (int i = 0; i < 2; ++i) inv[i] = exp2f(-(float)(2 * j + i) * (13.287712379549449f / 16.f));
    float cw[3][8];
#pragma unroll
    for (int t = 0; t < 3; ++t)
#pragma unroll
        for (int i = 0; i < 8; ++i) cw[t][i] = p.a_conv[t * 512 + 8 * lane + i];
#define MLA_LOAD(T, m) do { const int m_ = (m); const int pos_ = m_ < MP ? (m_ & 4095) : ((m_ - MP) & 2047); const int Sb_ = m_ < MP ? 4096 : 2048; \
        const bf16_t* pr_ = P0 + (size_t)m_ * LDP0; \
        T.cq = *(const u32x2*)(pr_ + 2048 + 4 * lane); T.ckv = *(const unsigned*)(pr_ + 2304 + 2 * lane); \
        T.kra = *(const unsigned*)(pr_ + 2432 + 2 * j); T.krb = *(const unsigned*)(pr_ + 2448 + 2 * j); \
        const bf16_t* qr_ = QU + (size_t)m_ * 768 + h * 96; \
        T.q8 = *(const u32x4*)(qr_ + 8 * j); T.qa = *(const unsigned*)(qr_ + 64 + 2 * j); T.qb = *(const unsigned*)(qr_ + 80 + 2 * j); \
        const bf16_t* kv_ = KV + (size_t)m_ * 1024 + h * 128; \
        T.k8 = *(const u32x4*)(kv_ + 8 * j); T.v8 = *(const u32x4*)(kv_ + 64 + 8 * j); \
        T.bz = *(const u32x4*)(pr_ + 512 + 8 * lane); T.cx1 = *(const u32x4*)(pr_ + 8 * lane); \
        T.cx0 = *(const u32x4*)(pr_ - (pos_ > 0 ? LDP0 : 0) + 8 * lane); T.cx2 = *(const u32x4*)(pr_ + (pos_ < Sb_ - 1 ? LDP0 : 0) + 8 * lane); } while (0)
#define MLA_COMPUTE(T, m) do { const int m_ = (m); const int pos = m_ < MP ? (m_ & 4095) : ((m_ - MP) & 2047); const int Sb = m_ < MP ? 4096 : 2048; \
        bf16_t* qrow = QU + (size_t)m_ * 768 + h * 96; bf16_t* kvrow = KV + (size_t)m_ * 1024; \
        const float sq = bflo(T.cq.x) * bflo(T.cq.x) + bfhi(T.cq.x) * bfhi(T.cq.x) + bflo(T.cq.y) * bflo(T.cq.y) + bfhi(T.cq.y) * bfhi(T.cq.y); \
        const float rstd_q = __builtin_amdgcn_rsqf(wave_sum(sq) * (1.f / 256.f) + EPS); \
        const float skv = bflo(T.ckv) * bflo(T.ckv) + bfhi(T.ckv) * bfhi(T.ckv); \
        const float rstd_kv = __builtin_amdgcn_rsqf(wave_sum(skv) * (1.f / 128.f) + EPS); \
        float cs[2], sn[2]; \
        _Pragma("unroll") for (int i = 0; i < 2; ++i) { const float angf = (float)pos * inv[i]; const double a_ = (double)angf; const double n_ = rint(a_ * 0.15915494309189535); \
            const float rf = (float)(a_ - n_ * 6.283185307179586); cs[i] = __cosf(rf); sn[i] = __sinf(rf); } \
        { float x[12]; \
          x[0] = bflo(T.q8.x); x[1] = bfhi(T.q8.x); x[2] = bflo(T.q8.y); x[3] = bfhi(T.q8.y); x[4] = bflo(T.q8.z); x[5] = bfhi(T.q8.z); x[6] = bflo(T.q8.w); x[7] = bfhi(T.q8.w); \
          x[8] = bflo(T.qa); x[9] = bfhi(T.qa); x[10] = bflo(T.qb); x[11] = bfhi(T.qb); \
          float ss = 0.f; \
          _Pragma("unroll") for (int i = 0; i < 12; ++i) { x[i] *= rstd_q; ss += x[i] * x[i]; } \
          const float r = __builtin_amdgcn_rsqf(sum8(ss) * (1.f / 96.f) + EPS) * QSCALE_B; \
          _Pragma("unroll") for (int i = 0; i < 12; ++i) x[i] *= r * qg[i]; \
          const float o8 = x[8] * cs[0] - x[10] * sn[0], o10 = x[8] * sn[0] + x[10] * cs[0]; \
          const float o9 = x[9] * cs[1] - x[11] * sn[1], o11 = x[9] * sn[1] + x[11] * cs[1]; \
          u32x4 w; w.x = pk2(x[0], x[1]); w.y = pk2(x[2], x[3]); w.z = pk2(x[4], x[5]); w.w = pk2(x[6], x[7]); \
          *(u32x4*)(qrow + 8 * j) = w; *(unsigned*)(qrow + 64 + 2 * j) = pk2(o8, o9); *(unsigned*)(qrow + 80 + 2 * j) = pk2(o10, o11); } \
        { float x[12]; \
          x[0] = bflo(T.k8.x); x[1] = bfhi(T.k8.x); x[2] = bflo(T.k8.y); x[3] = bfhi(T.k8.y); x[4] = bflo(T.k8.z); x[5] = bfhi(T.k8.z); x[6] = bflo(T.k8.w); x[7] = bfhi(T.k8.w); \
          _Pragma("unroll") for (int i = 0; i < 8; ++i) x[i] *= rstd_kv; \
          x[8] = bflo(T.kra); x[9] = bfhi(T.kra); x[10] = bflo(T.krb); x[11] = bfhi(T.krb); \
          float ss = 0.f; \
          _Pragma("unroll") for (int i = 0; i < 12; ++i) ss += x[i] * x[i]; \
          const float r = __builtin_amdgcn_rsqf(sum8(ss) * (1.f / 96.f) + EPS); \
          _Pragma("unroll") for (int i = 0; i < 12; ++i) x[i] *= r * kg[i]; \
          const float o8 = x[8] * cs[0] - x[10] * sn[0], o10 = x[8] * sn[0] + x[10] * cs[0]; \
          const float o9 = x[9] * cs[1] - x[11] * sn[1], o11 = x[9] * sn[1] + x[11] * cs[1]; \
          bf16_t* krow = kvrow + h * 96; \
          u32x4 w; w.x = pk2(x[0], x[1]); w.y = pk2(x[2], x[3]); w.z = pk2(x[4], x[5]); w.w = pk2(x[6], x[7]); \
          *(u32x4*)(krow + 8 * j) = w; *(unsigned*)(krow + 64 + 2 * j) = pk2(o8, o9); *(unsigned*)(krow + 80 + 2 * j) = pk2(o10, o11); } \
        { u32x4 w; w.x = pk2(bflo(T.v8.x) * rstd_kv, bfhi(T.v8.x) * rstd_kv); w.y = pk2(bflo(T.v8.y) * rstd_kv, bfhi(T.v8.y) * rstd_kv); \
          w.z = pk2(bflo(T.v8.z) * rstd_kv, bfhi(T.v8.z) * rstd_kv); w.w = pk2(bflo(T.v8.w) * rstd_kv, bfhi(T.v8.w) * rstd_kv); \
          *(u32x4*)(Vb + (size_t)m_ * 512 + h * 64 + 8 * j) = w; } \
        { const float fp = pos > 0 ? 1.f : 0.f, fn = pos < Sb - 1 ? 1.f : 0.f; float y[8]; \
          _Pragma("unroll") for (int i = 0; i < 4; ++i) { \
              const float cvl = cw[0][2 * i] * (fp * bflo(T.cx0[i])) + cw[1][2 * i] * bflo(T.cx1[i]) + cw[2][2 * i] * (fn * bflo(T.cx2[i])); \
              const float cvh = cw[0][2 * i + 1] * (fp * bfhi(T.cx0[i])) + cw[1][2 * i + 1] * bfhi(T.cx1[i]) + cw[2][2 * i + 1] * (fn * bfhi(T.cx2[i])); \
              y[2 * i] = bflo(T.bz[i]) * cvl; y[2 * i + 1] = bfhi(T.bz[i]) * cvh; } \
          u32x4 w; w.x = pk2(y[0], y[1]); w.y = pk2(y[2], y[3]); w.z = pk2(y[4], y[5]); w.w = pk2(y[6], y[7]); \
          *(u32x4*)((bf16_t*)P0 + (size_t)m_ * LDP0 + 512 + 8 * lane) = w; } } while (0)
    MlaTok A, B;
    int m = gw;
    if (m < M) MLA_LOAD(A, m);
    for (; m < M; m += 2 * NGW) {
        const int m2 = m + NGW, m3 = m + 2 * NGW;
        if (m2 < M) { MLA_LOAD(B, m2); asm volatile("s_waitcnt vmcnt(13)" ::: "memory"); } else { VM_WAIT(); }
        MLA_COMPUTE(A, m);
        if (m2 < M) {
            if (m3 < M) { MLA_LOAD(A, m3); asm volatile("s_waitcnt vmcnt(13)" ::: "memory"); } else { VM_WAIT(); }
            MLA_COMPUTE(B, m2);
        }
    }
#undef MLA_LOAD
#undef MLA_COMPUTE
}

__device__ __forceinline__ void attn_dense_phase(const Params& p, LAS unsigned char* lds, int vcu) {
    const int tid = opaque_tid(), lane = tid & 63, wid = tid >> 6, r32 = lane & 31, hi = lane >> 5, j16 = lane & 15, g16 = lane >> 4;
    constexpr int KROW = 208, VROW = 192, KBUF = 128 * KROW, VBUF = 128 * VROW;
    const bf16_t* Qg = (const bf16_t*)((const unsigned char*)p.out + OUT_Q);
    const bf16_t* Kg = (const bf16_t*)((const unsigned char*)p.out + OUT_KV);
    const bf16_t* Vg = (const bf16_t*)(p.ws + WS_V);
    const bf16_t* P0 = (const bf16_t*)(p.ws + WS_P);
    bf16_t* YC = (bf16_t*)(p.ws + WS_H);
    LAS unsigned char* Kl = lds; LAS unsigned char* Vl = lds + 2 * KBUF;
    int krow[3], kcc[3], vrow[2], vcc[2];
#pragma unroll
    for (int i = 0; i < 3; ++i) { const int c = tid + 512 * i; krow[i] = c / 12; kcc[i] = c % 12; }
#pragma unroll
    for (int i = 0; i < 2; ++i) { const int c = tid + 512 * i; vrow[i] = c >> 3; vcc[i] = c & 7; }
    const unsigned vrd = (unsigned)(uintptr_t)Vl + (unsigned)((4 * hi + (j16 >> 2)) * VROW + (16 * (g16 & 1) + 4 * (j16 & 3)) * 2);
    for (int it = 0; it < 12; ++it) {
        int S, mb, h, qb;
        if (it < 4) { const int u = vcu + 256 * it; const int bh = u >> 4; qb = u & 15; h = bh & 7; S = 4096; mb = (bh >> 3) * 4096; }
        else { const int u = vcu + 256 * (it - 4); const int bh = u >> 3; qb = u & 7; h = bh & 7; S = 2048; mb = MP + (bh >> 3) * 2048; }
        const int mq = mb + qb * 256 + wid * 32 + r32;
        bf16x8 qf[6];
#pragma unroll
        for (int k0 = 0; k0 < 6; ++k0) qf[k0] = *(const bf16x8*)(Qg + (size_t)mq * 768 + h * 96 + k0 * 16 + hi * 8);
        f32x16 o0 = {}, o1 = {};
        float m_run = -1e30f, l_run = 0.f;
        const int NT = S >> 7;
        u32x4 kreg[3], vreg[2];
#define A_LOAD(t) do { const size_t mk = (size_t)(mb + (t) * 128); \
        _Pragma("unroll") for (int i = 0; i < 3; ++i) kreg[i] = *(const u32x4*)(Kg + (mk + krow[i]) * 1024 + h * 96 + kcc[i] * 8); \
        _Pragma("unroll") for (int i = 0; i < 2; ++i) vreg[i] = *(const u32x4*)(Vg + (mk + vrow[i]) * 512 + h * 64 + vcc[i] * 8); } while (0)
#define A_WRITE(b) do { \
        _Pragma("unroll") for (int i = 0; i < 3; ++i) *(LAS u32x4*)(Kl + (b) * KBUF + krow[i] * KROW + kcc[i] * 16) = kreg[i]; \
        _Pragma("unroll") for (int i = 0; i < 2; ++i) *(LAS u32x4*)(Vl + (b) * VBUF + vrow[i] * VROW + vcc[i] * 16) = vreg[i]; } while (0)
        A_LOAD(0); A_WRITE(0); __syncthreads();
        for (int t = 0; t < NT; ++t) {
            const int b = t & 1;
            if (t + 1 < NT) A_LOAD(t + 1);
            const LAS unsigned char* Kb = Kl + b * KBUF;
            const unsigned vb = vrd + (unsigned)(b * VBUF);
#pragma unroll
            for (int kh = 0; kh < 2; ++kh) {
                f32x16 s0 = {}, s1 = {};
#pragma unroll
                for (int k0 = 0; k0 < 6; ++k0) {
                    const bf16x8 a0 = *(const LAS bf16x8*)(Kb + (kh * 64 + r32) * KROW + (k0 * 16 + hi * 8) * 2);
                    const bf16x8 a1 = *(const LAS bf16x8*)(Kb + (kh * 64 + 32 + r32) * KROW + (k0 * 16 + hi * 8) * 2);
                    s0 = __builtin_amdgcn_mfma_f32_32x32x16_bf16(a0, qf[k0], s0, 0, 0, 0);
                    s1 = __builtin_amdgcn_mfma_f32_32x32x16_bf16(a1, qf[k0], s1, 0, 0, 0);
                }
                s16x4 tv[4][4];
                { const unsigned vbh = vb + (unsigned)(kh * 64 * VROW);
                  tv[0][0] = tr_read<0 * 16 * VROW>(vbh); tv[0][1] = tr_read<0 * 16 * VROW + 8 * VROW>(vbh); tv[0][2] = tr_read<0 * 16 * VROW + 64>(vbh); tv[0][3] = tr_read<0 * 16 * VROW + 64 + 8 * VROW>(vbh);
                  tv[1][0] = tr_read<1 * 16 * VROW>(vbh); tv[1][1] = tr_read<1 * 16 * VROW + 8 * VROW>(vbh); tv[1][2] = tr_read<1 * 16 * VROW + 64>(vbh); tv[1][3] = tr_read<1 * 16 * VROW + 64 + 8 * VROW>(vbh);
                  tv[2][0] = tr_read<2 * 16 * VROW>(vbh); tv[2][1] = tr_read<2 * 16 * VROW + 8 * VROW>(vbh); tv[2][2] = tr_read<2 * 16 * VROW + 64>(vbh); tv[2][3] = tr_read<2 * 16 * VROW + 64 + 8 * VROW>(vbh);
                  tv[3][0] = tr_read<3 * 16 * VROW>(vbh); tv[3][1] = tr_read<3 * 16 * VROW + 8 * VROW>(vbh); tv[3][2] = tr_read<3 * 16 * VROW + 64>(vbh); tv[3][3] = tr_read<3 * 16 * VROW + 64 + 8 * VROW>(vbh); }
                float mx = s0[0];
#pragma unroll
                for (int r = 1; r < 16; ++r) mx = fmaxf(mx, s0[r]);
#pragma unroll
                for (int r = 0; r < 16; ++r) mx = fmaxf(mx, s1[r]);
                mx = swap_max(mx);
                if (__any(mx > m_run)) {
                    const float mn = fmaxf(m_run, mx), alpha = fexp2(m_run - mn); m_run = mn;
                    l_run *= alpha; o0 *= alpha; o1 *= alpha;
                }
                const float mn = m_run;
                float ls = 0.f;
#pragma unroll
                for (int r = 0; r < 16; ++r) { s0[r] = fexp2(s0[r] - mn); ls += s0[r]; }
#pragma unroll
                for (int r = 0; r < 16; ++r) { s1[r] = fexp2(s1[r] - mn); ls += s1[r]; }
                l_run += ls;
                bf16x8 pf[4];
                { u32x4 w;
                  w.x = pk2(s0[0], s0[1]); w.y = pk2(s0[2], s0[3]); w.z = pk2(s0[4], s0[5]); w.w = pk2(s0[6], s0[7]); pf[0] = *(bf16x8*)&w;
                  w.x = pk2(s0[8], s0[9]); w.y = pk2(s0[10], s0[11]); w.z = pk2(s0[12], s0[13]); w.w = pk2(s0[14], s0[15]); pf[1] = *(bf16x8*)&w;
                  w.x = pk2(s1[0], s1[1]); w.y = pk2(s1[2], s1[3]); w.z = pk2(s1[4], s1[5]); w.w = pk2(s1[6], s1[7]); pf[2] = *(bf16x8*)&w;
                  w.x = pk2(s1[8], s1[9]); w.y = pk2(s1[10], s1[11]); w.z = pk2(s1[12], s1[13]); w.w = pk2(s1[14], s1[15]); pf[3] = *(bf16x8*)&w; }
                LDS_WAIT(); SBAR();
#pragma unroll
                for (int J = 0; J < 4; ++J) {
                    o0 = __builtin_amdgcn_mfma_f32_32x32x16_bf16(PK8(tv[J][0], tv[J][1]), pf[J], o0, 0, 0, 0);
                    o1 = __builtin_amdgcn_mfma_f32_32x32x16_bf16(PK8(tv[J][2], tv[J][3]), pf[J], o1, 0, 0, 0);
                }
            }
            if (t + 1 < NT) A_WRITE(b ^ 1);
            __syncthreads();
        }
#undef A_LOAD
#undef A_WRITE
        const float linv = frcp(swap_sum(l_run));
        const bf16_t* zr = P0 + (size_t)mq * LDP0 + 2464 + h * 64;
        bf16_t* yr = (bf16_t*)P0 + (size_t)mq * LDP0 + 2464 + h * 64;
#pragma unroll
        for (int db = 0; db < 2; ++db)
#pragma unroll
            for (int rg = 0; rg < 4; ++rg) {
                const int d0 = db * 32 + 8 * rg + 4 * hi;
                const u32x2 z = *(const u32x2*)(zr + d0);
                const f32x16& o = db == 0 ? o0 : o1;
                const float y0 = o[4 * rg + 0] * linv * silu(bflo(z.x)), y1 = o[4 * rg + 1] * linv * silu(bfhi(z.x));
                const float y2 = o[4 * rg + 2] * linv * silu(bflo(z.y)), y3 = o[4 * rg + 3] * linv * silu(bfhi(z.y));
                u32x2 w; w.x = pk2(y0, y1); w.y = pk2(y2, y3);
                *(u32x2*)(yr + d0) = w;
            }
    }
}

template <bool NM>
__device__ __forceinline__ void attn_dense_phase3(const Params& p, LAS unsigned char* lds, int vcu) {
    const int tid = opaque_tid(), lane = tid & 63, wid = __builtin_amdgcn_readfirstlane(tid >> 6), r32 = lane & 31, hi = lane >> 5, j16 = lane & 15, g16 = lane >> 4;
    constexpr int KROW = 208, KBUF = 64 * KROW, VBUF = 64 * 128, TBUF = KBUF + VBUF;
    const bf16_t* Qg = (const bf16_t*)((const unsigned char*)p.out + OUT_Q);
    const bf16_t* Kg = (const bf16_t*)((const unsigned char*)p.out + OUT_KV);
    const bf16_t* Vg = (const bf16_t*)(p.ws + WS_V);
    const bf16_t* P0 = (const bf16_t*)(p.ws + WS_P);
    bf16_t* YC = (bf16_t*)(p.ws + WS_H);
    const bool lowhalf = wid < 4;
    int goff[3], gstep[3], loff[3];
    { const int c0 = tid; goff[0] = (c0 / 12) * 1024 + (c0 % 12) * 8; gstep[0] = 64 * 1024; loff[0] = (c0 / 12) * KROW + (c0 % 12) * 16; }
    if (lowhalf) { const int c1 = 512 + tid; goff[1] = (c1 / 12) * 1024 + (c1 % 12) * 8; gstep[1] = 64 * 1024; loff[1] = (c1 / 12) * KROW + (c1 % 12) * 16;
                   const int v2 = 256 + tid; const int row = v2 >> 3, c = v2 & 7; goff[2] = row * 512 + c * 8; gstep[2] = 64 * 512; loff[2] = KBUF + row * 128 + ((c ^ (((row >> 1) & 1) << 2)) << 4); }
    else { const int v1 = tid - 256; const int row = v1 >> 3, c = v1 & 7; goff[1] = row * 512 + c * 8; gstep[1] = 64 * 512; loff[1] = KBUF + row * 128 + ((c ^ (((row >> 1) & 1) << 2)) << 4);
           goff[2] = 0; gstep[2] = 0; loff[2] = 0; }
    if (wid >= 4) __builtin_amdgcn_s_setprio(1);
    const int fsw = (j16 >> 3) & 1;
    const unsigned vrowb = (unsigned)(uintptr_t)lds + (unsigned)(KBUF + (4 * hi + (j16 >> 2)) * 128 + 32 * (g16 & 1) + 8 * (j16 & 3));
    const unsigned vb0 = vrowb + (unsigned)(fsw * 64), vb1 = vrowb + (unsigned)((1 - fsw) * 64);
    const LAS unsigned char* kfb = lds + r32 * KROW + hi * 16;
#pragma unroll 1
    for (int it = 0; it < 12; ++it) {
        int S, mb, h, qb;
        if (it < 4) { const int u = vcu + 256 * it; const int bh = u >> 4; qb = u & 15; h = bh & 7; S = 4096; mb = (bh >> 3) * 4096; }
        else { const int u = vcu + 256 * (it - 4); const int bh = u >> 3; qb = u & 7; h = bh & 7; S = 2048; mb = MP + (bh >> 3) * 2048; }
        const int mq = mb + qb * 256 + wid * 32 + r32;
        bf16x8 qf[6];
#pragma unroll
        for (int k0 = 0; k0 < 6; ++k0) qf[k0] = *(const bf16x8*)(Qg + (size_t)mq * 768 + h * 96 + k0 * 16 + hi * 8);
        f32x16 o0 = {}, o1 = {};
        float m_run = -1e30f, l_run = 0.f;
        const int NT = S >> 6;
        const bf16_t* gp0 = Kg + (size_t)mb * 1024 + h * 96 + goff[0];
        const bf16_t* gp1 = lowhalf ? Kg + (size_t)mb * 1024 + h * 96 + goff[1] : Vg + (size_t)mb * 512 + h * 64 + goff[1];
        const bf16_t* gp2 = Vg + (size_t)mb * 512 + h * 64 + goff[2];
        u32x4 sra[3];
#define B_LOAD(R, t) do { R[0] = *(const u32x4*)(gp0 + (size_t)(t) * gstep[0]); R[1] = *(const u32x4*)(gp1 + (size_t)(t) * gstep[1]); if (lowhalf) R[2] = *(const u32x4*)(gp2 + (size_t)(t) * gstep[2]); } while (0)
#define B_WRITE(R, bo) do { *(LAS u32x4*)(lds + (bo) + loff[0]) = R[0]; *(LAS u32x4*)(lds + (bo) + loff[1]) = R[1]; if (lowhalf) *(LAS u32x4*)(lds + (bo) + loff[2]) = R[2]; } while (0)
#define B_QK(SA, SB, bo) do { SA = (f32x16){}; SB = (f32x16){}; bf16x8 kfa[6], kfc[6]; \
        _Pragma("unroll") for (int k0 = 0; k0 < 6; ++k0) { kfa[k0] = *(const LAS bf16x8*)(kfb + (bo) + k0 * 32); kfc[k0] = *(const LAS bf16x8*)(kfb + (bo) + 32 * KROW + k0 * 32); } \
        _Pragma("unroll") for (int k0 = 0; k0 < 6; ++k0) { \
            SA = __builtin_amdgcn_mfma_f32_32x32x16_bf16(kfa[k0], qf[k0], SA, 0, 0, 0); SB = __builtin_amdgcn_mfma_f32_32x32x16_bf16(kfc[k0], qf[k0], SB, 0, 0, 0); } } while (0)
        __syncthreads();
        B_LOAD(sra, 0); B_WRITE(sra, 0); B_LOAD(sra, 1); B_WRITE(sra, TBUF); __syncthreads();
        f32x16 sa0, sa1, sb0, sb1;
        B_QK(sa0, sa1, 0);
        int bc = 0, bn = TBUF, bw = 2 * TBUF;
#define B_STAGE(C0, C1, N0, N1, t) do { \
        if ((t) + 2 < NT) B_LOAD(sra, (t) + 2); \
        s16x4 tv[4][4]; \
        { const unsigned a0 = vb0 + (unsigned)bc, a1 = vb1 + (unsigned)bc; \
          tv[0][0] = tr_read<0>(a0); tv[0][1] = tr_read<1024>(a0); tv[0][2] = tr_read<0>(a1); tv[0][3] = tr_read<1024>(a1); \
          tv[1][0] = tr_read<2048>(a0); tv[1][1] = tr_read<3072>(a0); tv[1][2] = tr_read<2048>(a1); tv[1][3] = tr_read<3072>(a1); \
          tv[2][0] = tr_read<4096>(a0); tv[2][1] = tr_read<5120>(a0); tv[2][2] = tr_read<4096>(a1); tv[2][3] = tr_read<5120>(a1); \
          tv[3][0] = tr_read<6144>(a0); tv[3][1] = tr_read<7168>(a0); tv[3][2] = tr_read<6144>(a1); tv[3][3] = tr_read<7168>(a1); } \
        bf16x8 kfa[6], kfc[6]; \
        _Pragma("unroll") for (int k0 = 0; k0 < 6; ++k0) { kfa[k0] = *(const LAS bf16x8*)(kfb + bn + k0 * 32); kfc[k0] = *(const LAS bf16x8*)(kfb + bn + 32 * KROW + k0 * 32); } \
        if (!NM) { \
        float mx = C0[0]; \
        _Pragma("unroll") for (int r = 1; r < 16; ++r) mx = fmaxf(mx, C0[r]); \
        _Pragma("unroll") for (int r = 0; r < 16; ++r) mx = fmaxf(mx, C1[r]); \
        mx = swap_max(mx); \
        if (__any(mx > m_run)) { const float mn_ = fmaxf(m_run, mx), alpha = fexp2(m_run - mn_); m_run = mn_; l_run *= alpha; o0 *= alpha; o1 *= alpha; } } \
        N0 = (f32x16){}; N1 = (f32x16){}; \
        _Pragma("unroll") for (int k0 = 0; k0 < 6; ++k0) { \
            N0 = __builtin_amdgcn_mfma_f32_32x32x16_bf16(kfa[k0], qf[k0], N0, 0, 0, 0); N1 = __builtin_amdgcn_mfma_f32_32x32x16_bf16(kfc[k0], qf[k0], N1, 0, 0, 0); } \
        const float mn = NM ? 0.f : m_run; float ls = 0.f; \
        _Pragma("unroll") for (int r = 0; r < 16; ++r) { C0[r] = NM ? fexp2(C0[r]) : fexp2(C0[r] - mn); ls += C0[r]; } \
        _Pragma("unroll") for (int r = 0; r < 16; ++r) { C1[r] = NM ? fexp2(C1[r]) : fexp2(C1[r] - mn); ls += C1[r]; } \
        l_run += ls; \
        bf16x8 pf[4]; \
        { u32x4 w; \
          w.x = pk2(C0[0], C0[1]); w.y = pk2(C0[2], C0[3]); w.z = pk2(C0[4], C0[5]); w.w = pk2(C0[6], C0[7]); pf[0] = *(bf16x8*)&w; \
          w.x = pk2(C0[8], C0[9]); w.y = pk2(C0[10], C0[11]); w.z = pk2(C0[12], C0[13]); w.w = pk2(C0[14], C0[15]); pf[1] = *(bf16x8*)&w; \
          w.x = pk2(C1[0], C1[1]); w.y = pk2(C1[2], C1[3]); w.z = pk2(C1[4], C1[5]); w.w = pk2(C1[6], C1[7]); pf[2] = *(bf16x8*)&w; \
          w.x = pk2(C1[8], C1[9]); w.y = pk2(C1[10], C1[11]); w.z = pk2(C1[12], C1[13]); w.w = pk2(C1[14], C1[15]); pf[3] = *(bf16x8*)&w; } \
        _Pragma("unroll") for (int g_ = 0; g_ < 12; ++g_) { __builtin_amdgcn_sched_group_barrier(0x008, 1, 0); __builtin_amdgcn_sched_group_barrier(0x002, 9, 0); } \
        LDS_WAIT(); SBAR(); \
        _Pragma("unroll") for (int J = 0; J < 4; ++J) { \
            o0 = __builtin_amdgcn_mfma_f32_32x32x16_bf16(PK8(tv[J][0], tv[J][1]), pf[J], o0, 0, 0, 0); \
            o1 = __builtin_amdgcn_mfma_f32_32x32x16_bf16(PK8(tv[J][2], tv[J][3]), pf[J], o1, 0, 0, 0); } \
        if ((t) + 2 < NT) B_WRITE(sra, bw); \
        __syncthreads(); \
        { const int tmp = bc; bc = bn; bn = bw; bw = tmp; } } while (0)
#pragma unroll 1
        for (int t = 0; t < NT; t += 2) {
            B_STAGE(sa0, sa1, sb0, sb1, t);
            B_STAGE(sb0, sb1, sa0, sa1, t + 1);
        }
#undef B_STAGE
#undef B_QK
#undef B_LOAD
#undef B_WRITE
        const float linv = frcp(swap_sum(l_run));
        const bf16_t* zr = P0 + (size_t)mq * LDP0 + 2464 + h * 64;
        bf16_t* yr = (bf16_t*)P0 + (size_t)mq * LDP0 + 2464 + h * 64;
#pragma unroll
        for (int db = 0; db < 2; ++db)
#pragma unroll
            for (int rg = 0; rg < 4; ++rg) {
                const int d0 = db * 32 + 8 * rg + 4 * hi;
                const u32x2 z = *(const u32x2*)(zr + d0);
                const f32x16& o = db == 0 ? o0 : o1;
                const float y0 = o[4 * rg + 0] * linv * silu(bflo(z.x)), y1 = o[4 * rg + 1] * linv * silu(bfhi(z.x));
                const float y2 = o[4 * rg + 2] * linv * silu(bflo(z.y)), y3 = o[4 * rg + 3] * linv * silu(bfhi(z.y));
                u32x2 w; w.x = pk2(y0, y1); w.y = pk2(y2, y3);
                *(u32x2*)(yr + d0) = w;
            }
    }
    __builtin_amdgcn_s_setprio(0);
}

template <bool NM>
__device__ __forceinline__ void attn_dense_phase7(const Params& p, LAS unsigned char* lds, int vcu) {
    const int tid = opaque_tid(), lane = tid & 63, wid = __builtin_amdgcn_readfirstlane(tid >> 6), r32 = lane & 31, hi = lane >> 5, j16 = lane & 15, g16 = lane >> 4;
    constexpr int KROW = 208, KBUF = 64 * KROW, VBUF = 64 * 128, TBUF = KBUF + VBUF;
    const bf16_t* Qg = (const bf16_t*)((const unsigned char*)p.out + OUT_Q);
    const bf16_t* Kg = (const bf16_t*)((const unsigned char*)p.out + OUT_KV);
    const bf16_t* Vg = (const bf16_t*)(p.ws + WS_V);
    const bf16_t* P0 = (const bf16_t*)(p.ws + WS_P);
    bf16_t* YC = (bf16_t*)(p.ws + WS_H);
    const bool lowhalf = wid < 4;
    int goff0, goff1, goff2 = 0, loff0, loff1, loff2 = 0;
    { const int c0 = tid; goff0 = (c0 / 12) * 1024 + (c0 % 12) * 8; loff0 = (c0 / 12) * KROW + (c0 % 12) * 16; }
    if (lowhalf) { const int c1 = 512 + tid; goff1 = (c1 / 12) * 1024 + (c1 % 12) * 8; loff1 = (c1 / 12) * KROW + (c1 % 12) * 16;
                   const int v2 = 256 + tid; const int row = v2 >> 3, c = v2 & 7; goff2 = row * 512 + c * 8; loff2 = KBUF + row * 128 + ((c ^ (((row >> 1) & 1) << 2)) << 4); }
    else { const int v1 = tid - 256; const int row = v1 >> 3, c = v1 & 7; goff1 = row * 512 + c * 8; loff1 = KBUF + row * 128 + ((c ^ (((row >> 1) & 1) << 2)) << 4); }
    const int fsw = (j16 >> 3) & 1;
    const unsigned vrowb = (unsigned)(uintptr_t)lds + (unsigned)(KBUF + (4 * hi + (j16 >> 2)) * 128 + 32 * (g16 & 1) + 8 * (j16 & 3));
    const unsigned vb0 = vrowb + (unsigned)(fsw * 64), vb1 = vrowb + (unsigned)((1 - fsw) * 64);
    const LAS unsigned char* kfb = lds + r32 * KROW + hi * 16;
#pragma unroll 1
    for (int it = 0; it < 12; ++it) {
        int S, mb, h, qb;
        if (it < 4) { const int u = vcu + 256 * it; const int bh = u >> 4; qb = u & 15; h = bh & 7; S = 4096; mb = (bh >> 3) * 4096; }
        else { const int u = vcu + 256 * (it - 4); const int bh = u >> 3; qb = u & 7; h = bh & 7; S = 2048; mb = MP + (bh >> 3) * 2048; }
        const int mq = mb + qb * 256 + wid * 32 + r32;
        bf16x8 qf[6];
#pragma unroll
        for (int k0 = 0; k0 < 6; ++k0) qf[k0] = *(const bf16x8*)(Qg + (size_t)mq * 768 + h * 96 + k0 * 16 + hi * 8);
        f32x16 o0 = {}, o1 = {};
        float m_run = -1e30f, l_run = 0.f;
        const int NT = S >> 6;
        const bf16_t* gp0 = Kg + (size_t)mb * 1024 + h * 96 + goff0;
        const int stride1 = lowhalf ? 64 * 1024 : 64 * 512;
        const bf16_t* gp1 = lowhalf ? Kg + (size_t)mb * 1024 + h * 96 + goff1 : Vg + (size_t)mb * 512 + h * 64 + goff1;
        const bf16_t* gp2 = Vg + (size_t)mb * 512 + h * 64 + goff2;
        u32x4 sra[3];
#define B_LOAD(R, t) do { R[0] = *(const u32x4*)gp0; R[1] = *(const u32x4*)gp1; if (lowhalf) R[2] = *(const u32x4*)gp2; gp0 += 64 * 1024; gp1 += stride1; gp2 += 64 * 512; } while (0)
#define B_WRITE(R, bo) do { *(LAS u32x4*)(lds + (bo) + loff0) = R[0]; *(LAS u32x4*)(lds + (bo) + loff1) = R[1]; if (lowhalf) *(LAS u32x4*)(lds + (bo) + loff2) = R[2]; } while (0)
#define B_QK(SA, SB, bo) do { SA = (f32x16){}; SB = (f32x16){}; bf16x8 kfa[6], kfc[6]; \
        _Pragma("unroll") for (int k0 = 0; k0 < 6; ++k0) { kfa[k0] = *(const LAS bf16x8*)(kfb + (bo) + k0 * 32); kfc[k0] = *(const LAS bf16x8*)(kfb + (bo) + 32 * KROW + k0 * 32); } \
        _Pragma("unroll") for (int k0 = 0; k0 < 6; ++k0) { \
            SA = __builtin_amdgcn_mfma_f32_32x32x16_bf16(kfa[k0], qf[k0], SA, 0, 0, 0); SB = __builtin_amdgcn_mfma_f32_32x32x16_bf16(kfc[k0], qf[k0], SB, 0, 0, 0); } } while (0)
        __syncthreads();
        *(LAS u32x4*)(lds + 3 * TBUF + KBUF + tid * 16) = (u32x4){0u, 0u, 0u, 0u};
        B_LOAD(sra, 0); B_WRITE(sra, 0); B_LOAD(sra, 1); B_WRITE(sra, TBUF); __syncthreads();
        B_LOAD(sra, 2);
        f32x16 sa0, sa1, sb0, sb1;
        B_QK(sa0, sa1, 0);
        int bp = 3 * TBUF, bc = 0, bn = TBUF, bw = 2 * TBUF;
        bf16x8 pfa[4], pfb[4];
#pragma unroll
        for (int J = 0; J < 4; ++J) { pfa[J] = (bf16x8){0, 0, 0, 0, 0, 0, 0, 0}; pfb[J] = pfa[J]; }
#define G_STAGE(C0, C1, N0, N1, PP, PN, t) do { \
        if ((t) + 2 < NT) B_WRITE(sra, bw);        \
        if ((t) + 3 < NT) B_LOAD(sra, (t) + 3); \
        const unsigned va0 = vb0 + (unsigned)bp, va1 = vb1 + (unsigned)bp; \
        s16x4 tv[4][4]; \
        tv[0][0] = tr_read<0>(va0); tv[0][1] = tr_read<1024>(va0); tv[0][2] = tr_read<0>(va1); tv[0][3] = tr_read<1024>(va1); \
        tv[1][0] = tr_read<2048>(va0); tv[1][1] = tr_read<3072>(va0); tv[1][2] = tr_read<2048>(va1); tv[1][3] = tr_read<3072>(va1); \
          \
        N0 = (f32x16){}; N1 = (f32x16){}; \
        _Pragma("unroll") for (int k0 = 0; k0 < 6; ++k0) { \
            const bf16x8 ka_ = *(const LAS bf16x8*)(kfb + bn + k0 * 32), kc_ = *(const LAS bf16x8*)(kfb + bn + 32 * KROW + k0 * 32); \
            N0 = __builtin_amdgcn_mfma_f32_32x32x16_bf16(ka_, qf[k0], N0, 0, 0, 0); N1 = __builtin_amdgcn_mfma_f32_32x32x16_bf16(kc_, qf[k0], N1, 0, 0, 0); } \
        float ls = 0.f; \
        _Pragma("unroll") for (int r = 0; r < 16; ++r) { C0[r] = fexp2(C0[r]); ls += C0[r]; } \
        { u32x4 w; \
          w.x = pk2(C0[0], C0[1]); w.y = pk2(C0[2], C0[3]); w.z = pk2(C0[4], C0[5]); w.w = pk2(C0[6], C0[7]); PN[0] = *(bf16x8*)&w; \
          w.x = pk2(C0[8], C0[9]); w.y = pk2(C0[10], C0[11]); w.z = pk2(C0[12], C0[13]); w.w = pk2(C0[14], C0[15]); PN[1] = *(bf16x8*)&w; } \
        _Pragma("unroll") for (int g_ = 0; g_ < 12; ++g_) { __builtin_amdgcn_sched_group_barrier(0x008, 1, 0); __builtin_amdgcn_sched_group_barrier(0x002, 4, 0); } \
        LDS_WAIT(); SBAR(); \
          \
        tv[2][0] = tr_read<4096>(va0); tv[2][1] = tr_read<5120>(va0); tv[2][2] = tr_read<4096>(va1); tv[2][3] = tr_read<5120>(va1); \
        tv[3][0] = tr_read<6144>(va0); tv[3][1] = tr_read<7168>(va0); tv[3][2] = tr_read<6144>(va1); tv[3][3] = tr_read<7168>(va1); \
        _Pragma("unroll") for (int J = 0; J < 2; ++J) { \
            o0 = __builtin_amdgcn_mfma_f32_32x32x16_bf16(PK8(tv[J][0], tv[J][1]), PP[J], o0, 0, 0, 0); \
            o1 = __builtin_amdgcn_mfma_f32_32x32x16_bf16(PK8(tv[J][2], tv[J][3]), PP[J], o1, 0, 0, 0); } \
        _Pragma("unroll") for (int r = 0; r < 8; ++r) { C1[r] = fexp2(C1[r]); ls += C1[r]; } \
        { u32x4 w; w.x = pk2(C1[0], C1[1]); w.y = pk2(C1[2], C1[3]); w.z = pk2(C1[4], C1[5]); w.w = pk2(C1[6], C1[7]); PN[2] = *(bf16x8*)&w; } \
        _Pragma("unroll") for (int g_ = 0; g_ < 4; ++g_) { __builtin_amdgcn_sched_group_barrier(0x008, 1, 0); __builtin_amdgcn_sched_group_barrier(0x002, 5, 0); } \
        LDS_WAIT(); SBAR(); \
          \
        _Pragma("unroll") for (int J = 2; J < 4; ++J) { \
            o0 = __builtin_amdgcn_mfma_f32_32x32x16_bf16(PK8(tv[J][0], tv[J][1]), PP[J], o0, 0, 0, 0); \
            o1 = __builtin_amdgcn_mfma_f32_32x32x16_bf16(PK8(tv[J][2], tv[J][3]), PP[J], o1, 0, 0, 0); } \
        _Pragma("unroll") for (int r = 8; r < 16; ++r) { C1[r] = fexp2(C1[r]); ls += C1[r]; } \
        l_run += ls; \
        { u32x4 w; w.x = pk2(C1[8], C1[9]); w.y = pk2(C1[10], C1[11]); w.z = pk2(C1[12], C1[13]); w.w = pk2(C1[14], C1[15]); PN[3] = *(bf16x8*)&w; } \
        _Pragma("unroll") for (int g_ = 0; g_ < 4; ++g_) { __builtin_amdgcn_sched_group_barrier(0x008, 1, 0); __builtin_amdgcn_sched_group_barrier(0x002, 5, 0); } \
        SBAR(); \
        __syncthreads(); \
        { const int tmp = bp; bp = bc; bc = bn; bn = bw; bw = tmp; } } while (0)
#pragma unroll 1
        for (int t = 0; t < NT; t += 2) {
            G_STAGE(sa0, sa1, sb0, sb1, pfb, pfa, t);
            G_STAGE(sb0, sb1, sa0, sa1, pfa, pfb, t + 1);
        }
#undef G_STAGE
        {
            const unsigned a0 = vb0 + (unsigned)bp, a1 = vb1 + (unsigned)bp;
            s16x4 tv[4][4];
            tv[0][0] = tr_read<0>(a0); tv[0][1] = tr_read<1024>(a0); tv[0][2] = tr_read<0>(a1); tv[0][3] = tr_read<1024>(a1);
            tv[1][0] = tr_read<2048>(a0); tv[1][1] = tr_read<3072>(a0); tv[1][2] = tr_read<2048>(a1); tv[1][3] = tr_read<3072>(a1);
            tv[2][0] = tr_read<4096>(a0); tv[2][1] = tr_read<5120>(a0); tv[2][2] = tr_read<4096>(a1); tv[2][3] = tr_read<5120>(a1);
            tv[3][0] = tr_read<6144>(a0); tv[3][1] = tr_read<7168>(a0); tv[3][2] = tr_read<6144>(a1); tv[3][3] = tr_read<7168>(a1);
            LDS_WAIT(); SBAR();
#pragma unroll
            for (int J = 0; J < 4; ++J) {
                o0 = __builtin_amdgcn_mfma_f32_32x32x16_bf16(PK8(tv[J][0], tv[J][1]), pfb[J], o0, 0, 0, 0);
                o1 = __builtin_amdgcn_mfma_f32_32x32x16_bf16(PK8(tv[J][2], tv[J][3]), pfb[J], o1, 0, 0, 0); }
        }
#undef B_QK
#undef B_LOAD
#undef B_WRITE
        int mqe = mb + qb * 256 + wid * 32 + r32; asm volatile("" : "+v"(mqe));
        const float linv = frcp(swap_sum(l_run));
        const bf16_t* zr = P0 + (size_t)mqe * LDP0 + 2464 + h * 64;
        bf16_t* yr = (bf16_t*)P0 + (size_t)mqe * LDP0 + 2464 + h * 64;
#pragma unroll
        for (int db = 0; db < 2; ++db)
#pragma unroll
            for (int rg = 0; rg < 4; ++rg) {
                const int d0 = db * 32 + 8 * rg + 4 * hi;
                const u32x2 z = *(const u32x2*)(zr + d0);
                const f32x16& o = db == 0 ? o0 : o1;
                const float y0 = o[4 * rg + 0] * linv * silu(bflo(z.x)), y1 = o[4 * rg + 1] * linv * silu(bfhi(z.x));
                const float y2 = o[4 * rg + 2] * linv * silu(bflo(z.y)), y3 = o[4 * rg + 3] * linv * silu(bfhi(z.y));
                u32x2 w; w.x = pk2(y0, y1); w.y = pk2(y2, y3);
                *(u32x2*)(yr + d0) = w;
            }
    }
    __builtin_amdgcn_s_setprio(0);
}

__device__ __forceinline__ void odd_prep_phase(const Params& p, int vcu, int G) {
    const int tid = opaque_tid(), lane = tid & 63, wave = tid >> 6, j = lane & 7;
    const int gw = vcu * 8 + wave, NGW = G * 8;
    bf16_t* P1 = (bf16_t*)(p.ws + WS_P);
    float vg[8], vbv[8], qg[8], kg[8];
#pragma unroll
    for (int i = 0; i < 8; ++i) { vg[i] = p.vn_g[8 * lane + i]; vbv[i] = p.vn_b[8 * lane + i]; qg[i] = p.dq_gain[8 * j + i] * QSCALE_D; kg[i] = p.dk_gain[8 * j + i]; }
    for (int m = gw; m < M; m += NGW) {
        bf16_t* pr = P1 + (size_t)m * LDP1;
        const u32x4 cv = *(const u32x4*)(pr + 512 + 8 * lane), dq = *(const u32x4*)(pr + 1536 + 8 * lane), dk = *(const u32x4*)(pr + 2048 + 8 * lane);
        float x[8];
#pragma unroll
        for (int i = 0; i < 4; ++i) { x[2 * i] = gelu_t(bflo(cv[i])); x[2 * i + 1] = gelu_t(bfhi(cv[i])); }
        float s = 0.f;
#pragma unroll
        for (int i = 0; i < 8; ++i) s += x[i];
        const float mean = wave_sum(s) * (1.f / 512.f);
        float s2 = 0.f;
#pragma unroll
        for (int i = 0; i < 8; ++i) { x[i] -= mean; s2 += x[i] * x[i]; }
        const float rstd = __builtin_amdgcn_rsqf(wave_sum(s2) * (1.f / 512.f) + EPS);
        u32x4 w;
#pragma unroll
        for (int i = 0; i < 4; ++i) w[i] = pk2(x[2 * i] * rstd * vg[2 * i] + vbv[2 * i], x[2 * i + 1] * rstd * vg[2 * i + 1] + vbv[2 * i + 1]);
        *(u32x4*)(pr + 512 + 8 * lane) = w;
        float q[8], k[8]; float sq = 0.f, sk = 0.f;
#pragma unroll
        for (int i = 0; i < 4; ++i) { q[2 * i] = bflo(dq[i]); q[2 * i + 1] = bfhi(dq[i]); k[2 * i] = bflo(dk[i]); k[2 * i + 1] = bfhi(dk[i]); }
#pragma unroll
        for (int i = 0; i < 8; ++i) { sq += q[i] * q[i]; sk += k[i] * k[i]; }
        const float rq = __builtin_amdgcn_rsqf(sum8(sq) * (1.f / 64.f) + EPS), rk = __builtin_amdgcn_rsqf(sum8(sk) * (1.f / 64.f) + EPS);
        u32x4 wq, wk;
#pragma unroll
        for (int i = 0; i < 4; ++i) { wq[i] = pk2(q[2 * i] * rq * qg[2 * i], q[2 * i + 1] * rq * qg[2 * i + 1]); wk[i] = pk2(k[2 * i] * rk * kg[2 * i], k[2 * i + 1] * rk * kg[2 * i + 1]); }
        *(u32x4*)(pr + 1536 + 8 * lane) = wq; *(u32x4*)(pr + 2048 + 8 * lane) = wk;
    }
}

__device__ __forceinline__ void gmlp_phase(const Params& p, LAS unsigned char* lds, int vcu) {
    const int tid = opaque_tid(), lane = tid & 63, wid = tid >> 6, r32 = lane & 31, hi = lane >> 5, j16 = lane & 15, g16 = lane >> 4;
    constexpr int VVROW = 1088;
    const bf16_t* P1 = (const bf16_t*)(p.ws + WS_P);
    const bf16_t* Ws = (const bf16_t*)(p.ws + WS_CWS);
    bf16_t* YC = (bf16_t*)(p.ws + WS_H);
    const int g = wid >> 1, chalf = wid & 1;
    const int cbase = g * 128 + chalf * 64;
    float vg[8], vbv[8];
#pragma unroll
    for (int e = 0; e < 8; ++e) { vg[e] = p.vn_g[8 * lane + e]; vbv[e] = p.vn_b[8 * lane + e]; }
    const unsigned vrd = (unsigned)(uintptr_t)lds + (unsigned)((hi * 8 + (j16 >> 2)) * VVROW + (cbase + 16 * (g16 & 1) + 4 * (j16 & 3)) * 2);
    for (int it = 0; it < 3; ++it) {
        const int ci = vcu + 256 * it; const int m0 = ci * 128;
        __syncthreads();
#pragma unroll 4
        for (int i = 0; i < 16; ++i) { const int row = wid + 8 * i;
            const u32x4 v = *(const u32x4*)(P1 + (size_t)(m0 + row) * LDP1 + 512 + lane * 8);
            float x[8];
#pragma unroll
            for (int e = 0; e < 4; ++e) { x[2 * e] = gelu_t(bflo(v[e])); x[2 * e + 1] = gelu_t(bfhi(v[e])); }
            float sm = 0.f;
#pragma unroll
            for (int e = 0; e < 8; ++e) sm += x[e];
            const float mean = wave_sum(sm) * (1.f / 512.f);
            float s2 = 0.f;
#pragma unroll
            for (int e = 0; e < 8; ++e) { x[e] -= mean; s2 += x[e] * x[e]; }
            const float rstd = __builtin_amdgcn_rsqf(wave_sum(s2) * (1.f / 512.f) + EPS);
            u32x4 w;
#pragma unroll
            for (int e = 0; e < 4; ++e) w[e] = pk2(x[2 * e] * rstd * vg[2 * e] + vbv[2 * e], x[2 * e + 1] * rstd * vg[2 * e + 1] + vbv[2 * e + 1]);
            *(LAS u32x4*)(lds + row * VVROW + lane * 16) = w; }
        __syncthreads();
#pragma unroll 1
        for (int pb = 0; pb < 4; ++pb) {
            f32x16 a0 = {}, a1 = {};
            const bf16_t* wsr = Ws + ((size_t)g * 128 + pb * 32 + r32) * 128 + hi * 8;
#pragma unroll
            for (int ks = 0; ks < 8; ++ks) {
                const bf16x8 bfr = *(const bf16x8*)(wsr + ks * 16);
                const unsigned va = vrd + (unsigned)(ks * 16 * VVROW);
                const s16x4 t00 = tr_read<0>(va), t01 = tr_read<4 * VVROW>(va), t10 = tr_read<64>(va), t11 = tr_read<64 + 4 * VVROW>(va);
                LDS_WAIT(); SBAR();
                a0 = __builtin_amdgcn_mfma_f32_32x32x16_bf16(PK8(t00, t01), bfr, a0, 0, 0, 0);
                a1 = __builtin_amdgcn_mfma_f32_32x32x16_bf16(PK8(t10, t11), bfr, a1, 0, 0, 0);
            }
            const int pl = pb * 32 + r32; const int m = m0 + pl;
            const float bsv = p.c_bs[g * 128 + pl];
            const bf16_t* pr = P1 + (size_t)m * LDP1;
#pragma unroll
            for (int cb = 0; cb < 2; ++cb)
#pragma unroll
                for (int rg = 0; rg < 4; ++rg) {
                    const int c4 = cbase + cb * 32 + 8 * rg + 4 * hi;
                    const u32x2 cu = *(const u32x2*)(pr + c4), cz = *(const u32x2*)(pr + 1024 + c4);
                    const f32x16& a = cb == 0 ? a0 : a1;
                    const float y0 = gelu_t(bflo(cu.x)) * (a[4 * rg + 0] + bsv) * silu(bflo(cz.x)), y1 = gelu_t(bfhi(cu.x)) * (a[4 * rg + 1] + bsv) * silu(bfhi(cz.x));
                    const float y2 = gelu_t(bflo(cu.y)) * (a[4 * rg + 2] + bsv) * silu(bflo(cz.y)), y3 = gelu_t(bfhi(cu.y)) * (a[4 * rg + 3] + bsv) * silu(bfhi(cz.y));
                    u32x2 w; w.x = pk2(y0, y1); w.y = pk2(y2, y3);
                    *(u32x2*)(YC + (size_t)m * D + c4) = w;
                }
        }
    }
}

__device__ __forceinline__ void dilated_phase(const Params& p, LAS unsigned char* lds, int vcu, int G) {
    const int tid = opaque_tid(), lane = tid & 63, wid = tid >> 6, r32 = lane & 31, hi = lane >> 5, j16 = lane & 15, g16 = lane >> 4;
    constexpr int VROW = 192, VBUF = 32 * VROW;
    bf16_t* P1 = (bf16_t*)(p.ws + WS_P);
    float* LSE = (float*)(p.ws + WS_LSE);
    LAS float* bt = (LAS float*)lds;
    LAS unsigned char* vl = lds + 16384 + wid * (2 * VBUF);
    __syncthreads();
    { const float* bsrc = (const float*)(p.ws + WS_BIAS); for (int i = tid; i < 3 * 8 * 129; i += 512) bt[i] = bsrc[i]; }
    __syncthreads();
    const unsigned vrd = (unsigned)(uintptr_t)vl + (unsigned)((4 * hi + (j16 >> 2)) * VROW + (16 * (g16 & 1) + 4 * (j16 & 3)) * 2);
    const int gw = vcu * 8 + wid, NGW = G * 8;
    constexpr int NTASK = 3 * 8 * (M / 32);
#pragma unroll 1
    for (int task = gw; task < NTASK; task += NGW) {
        const int T = task % (M / 32); const int gh = task / (M / 32); const int h = gh & 7, g = gh >> 3;
        const int dsh = 2 * g;
        int mb, tt, Sb;
        if (T < 1024) { mb = (T >> 7) * 4096; tt = T & 127; Sb = 4096; } else { const int t2 = T - 1024; mb = MP + (t2 >> 6) * 2048; tt = t2 & 63; Sb = 2048; }
        const int L = Sb >> dsh, tpr = L >> 5;
        const int res = tt / tpr, u0 = (tt % tpr) * 32;
        const int tq = mb + res + ((u0 + r32) << dsh);
        bf16x8 qf[4];
#pragma unroll
        for (int k0 = 0; k0 < 4; ++k0) qf[k0] = *(const bf16x8*)(P1 + (size_t)tq * LDP1 + 1536 + h * 64 + k0 * 16 + hi * 8);
        f32x16 s[5];
        const LAS float* btg = bt + (g * 8 + h) * 129;
#pragma unroll
        for (int kb = 0; kb < 5; ++kb) {
            int ku = u0 - 64 + kb * 32 + r32; ku = ku < 0 ? 0 : (ku >= L ? L - 1 : ku);
            const bf16_t* kr = P1 + (size_t)(mb + res + (ku << dsh)) * LDP1 + 2048 + h * 64 + hi * 8;
            bf16x8 kf[4];
#pragma unroll
            for (int k0 = 0; k0 < 4; ++k0) kf[k0] = *(const bf16x8*)(kr + k0 * 16);
            f32x16 a = {};
#pragma unroll
            for (int k0 = 0; k0 < 4; ++k0) a = __builtin_amdgcn_mfma_f32_32x32x16_bf16(kf[k0], qf[k0], a, 0, 0, 0);
#pragma unroll
            for (int r = 0; r < 16; ++r) {
                const int kl = kb * 32 + crow(r, hi); const int jj = kl - r32; const int kuu = u0 - 64 + kl;
                const bool ok = (jj >= 0) && (jj <= 128) && (kuu >= 0) && (kuu < L);
                const int jc = jj < 0 ? 0 : (jj > 128 ? 128 : jj);
                a[r] = ok ? a[r] + btg[jc] : -1e30f;
            }
            s[kb] = a;
        }
        float mx = -1e30f;
#pragma unroll
        for (int kb = 0; kb < 5; ++kb)
#pragma unroll
            for (int r = 0; r < 16; ++r) mx = fmaxf(mx, s[kb][r]);
        mx = swap_max(mx);
        float ls = 0.f;
#pragma unroll
        for (int kb = 0; kb < 5; ++kb)
#pragma unroll
            for (int r = 0; r < 16; ++r) { s[kb][r] = fexp2(s[kb][r] - mx); ls += s[kb][r]; }
        ls = swap_sum(ls);
        f32x16 o0 = {}, o1 = {};
        u32x4 vreg[4];
#define D_VLOAD(kb) do { int ku = u0 - 64 + (kb) * 32 + r32; ku = ku < 0 ? 0 : (ku >= L ? L - 1 : ku); \
        const bf16_t* vr = P1 + (size_t)(mb + res + (ku << dsh)) * LDP1 + 2560 + h * 64 + hi * 8; \
        _Pragma("unroll") for (int i = 0; i < 4; ++i) vreg[i] = *(const u32x4*)(vr + i * 16); } while (0)
        D_VLOAD(0);
#pragma unroll
        for (int kb = 0; kb < 5; ++kb) {
            LAS unsigned char* vbw = vl + (kb & 1) * VBUF + r32 * VROW + hi * 16;
#pragma unroll
            for (int i = 0; i < 4; ++i) *(LAS u32x4*)(vbw + i * 32) = vreg[i];
            if (kb < 4) D_VLOAD(kb + 1);
            LDS_WAIT();
            const unsigned vb = vrd + (unsigned)((kb & 1) * VBUF);
#pragma unroll
            for (int a = 0; a < 2; ++a) {
                const unsigned vba = vb + (unsigned)(a * 16 * VROW);
                const s16x4 t00 = tr_read<0>(vba), t01 = tr_read<8 * VROW>(vba), t10 = tr_read<64>(vba), t11 = tr_read<64 + 8 * VROW>(vba);
                LDS_WAIT(); SBAR();
                u32x4 w; w.x = pk2(s[kb][8 * a + 0], s[kb][8 * a + 1]); w.y = pk2(s[kb][8 * a + 2], s[kb][8 * a + 3]); w.z = pk2(s[kb][8 * a + 4], s[kb][8 * a + 5]); w.w = pk2(s[kb][8 * a + 6], s[kb][8 * a + 7]);
                const bf16x8 pf = *(bf16x8*)&w;
                o0 = __builtin_amdgcn_mfma_f32_32x32x16_bf16(PK8(t00, t01), pf, o0, 0, 0, 0);
                o1 = __builtin_amdgcn_mfma_f32_32x32x16_bf16(PK8(t10, t11), pf, o1, 0, 0, 0);
            }
        }
#undef D_VLOAD
        const float linv = frcp(ls);
        bf16_t* orow = P1 + (size_t)tq * LDP1 + g * 512 + h * 64;
#pragma unroll
        for (int db = 0; db < 2; ++db)
#pragma unroll
            for (int rg = 0; rg < 4; ++rg) {
                const f32x16& o = db == 0 ? o0 : o1;
                u32x2 w; w.x = pk2(o[4 * rg] * linv, o[4 * rg + 1] * linv); w.y = pk2(o[4 * rg + 2] * linv, o[4 * rg + 3] * linv);
                *(u32x2*)(orow + db * 32 + 8 * rg + 4 * hi) = w;
            }
        if (hi == 0) LSE[((size_t)g * M + tq) * 8 + h] = mx + __builtin_amdgcn_logf(ls);
    }
}

template <int MODE>
__device__ __forceinline__ void dilated_phase2(const Params& p, LAS unsigned char* lds, int vcu) {
    const int tid = opaque_tid(), lane = tid & 63, wid = __builtin_amdgcn_readfirstlane(tid >> 6), r32 = lane & 31, hi = lane >> 5, j16 = lane & 15, g16 = lane >> 4;
    const int hf = wid >> 2, wq = wid & 3, t = tid & 255;
    bf16_t* P1 = (bf16_t*)(p.ws + WS_P);
    float* LSE = (float*)(p.ws + WS_LSE);
    const float* BT = (const float*)(p.ws + WS_BIAS);
    LAS unsigned char* Kl = lds + hf * 66560; LAS unsigned char* Vl = Kl + 32768; LAS float* tbl = (LAS float*)(Kl + 65536);
    const int sw = (r32 >> 1) & 7;
    const LAS unsigned char* kfp[4];
#pragma unroll
    for (int k0 = 0; k0 < 4; ++k0) kfp[k0] = Kl + (32 * wq + r32) * 128 + (((2 * k0 + hi) ^ sw) << 4);
    const int fsw = (j16 >> 3) & 1;
    const unsigned vrowb = (unsigned)(uintptr_t)Vl + (unsigned)((32 * wq + 4 * hi + (j16 >> 2)) * 128 + 32 * (g16 & 1) + 8 * (j16 & 3));
    const unsigned vb0 = vrowb + (unsigned)(fsw * 64), vb1 = vrowb + (unsigned)((1 - fsw) * 64);
    const LAS float* tb = tbl + 31 - r32 + 4 * hi;
    const int hw = vcu * 2 + hf;
    constexpr int NUNITS = (MODE == 0 ? 2 : 1) * 8 * (M / 128), NU = NUNITS / 512;
    bf16_t* YC = (bf16_t*)(p.ws + WS_H);
    bf16x8 qf[4];
#pragma unroll 1
    for (int step = 0; step <= 2 * NU; ++step) {
        const int ph = step - hf;
        if (ph >= 0 && ph < 2 * NU) {
            const int unit = hw + 512 * (ph >> 1);
            const int T4 = unit % (M / 128); const int gh = unit / (M / 128) + (MODE == 0 ? 0 : 16); const int h = gh & 7, g = gh >> 3;
            const int dsh = 2 * g;
            int mb, tt, Sb;
            if (T4 < 256) { mb = (T4 >> 5) * 4096; tt = (T4 & 31) * 4; Sb = 4096; } else { const int t2 = T4 - 256; mb = MP + (t2 >> 4) * 2048; tt = (t2 & 15) * 4; Sb = 2048; }
            const int L = Sb >> dsh, tpr = L >> 5;
            const int res = tt / tpr, u0 = (tt % tpr) * 32;
            if ((ph & 1) == 0) {
                u32x4 kreg[8], vreg[8];
#pragma unroll
                for (int i = 0; i < 8; ++i) { const int idx = t + 256 * i; const int row = idx >> 3, c = idx & 7;
                    int ku = u0 - 64 + row; ku = ku < 0 ? 0 : (ku >= L ? L - 1 : ku);
                    const bf16_t* src = P1 + (size_t)(mb + res + (ku << dsh)) * LDP1 + h * 64 + c * 8;
                    kreg[i] = *(const u32x4*)(src + 2048); vreg[i] = *(const u32x4*)(src + 2560); }
                { const int tq = mb + res + ((u0 + 32 * wq + r32) << dsh);
#pragma unroll
                  for (int k0 = 0; k0 < 4; ++k0) qf[k0] = *(const bf16x8*)(P1 + (size_t)tq * LDP1 + 1536 + h * 64 + k0 * 16 + hi * 8); }
                if (t < 191) { const int jj = t - 31; tbl[t] = (jj >= 0 && jj <= 128) ? BT[(g * 8 + h) * 129 + jj] : -1e30f; }
#pragma unroll
                for (int i = 0; i < 8; ++i) { const int idx = t + 256 * i; const int row = idx >> 3, c = idx & 7;
                    *(LAS u32x4*)(Kl + row * 128 + ((c ^ ((row >> 1) & 7)) << 4)) = kreg[i];
                    *(LAS u32x4*)(Vl + row * 128 + ((c ^ (((row >> 1) & 1) << 2)) << 4)) = vreg[i]; }
            } else {
                f32x16 s[5];
#pragma unroll
                for (int kb = 0; kb < 5; ++kb) {
                    bf16x8 kf[4];
#pragma unroll
                    for (int k0 = 0; k0 < 4; ++k0) kf[k0] = *(const LAS bf16x8*)(kfp[k0] + kb * 4096);
                    f32x16 a = {};
#pragma unroll
                    for (int k0 = 0; k0 < 4; ++k0) a = __builtin_amdgcn_mfma_f32_32x32x16_bf16(kf[k0], qf[k0], a, 0, 0, 0);
#pragma unroll
                    for (int r = 0; r < 16; ++r) a[r] += tb[kb * 32 + 8 * (r >> 2) + (r & 3)];
                    s[kb] = a;
                }
                const int klo = u0 - 64 + 32 * wq;
                if (klo < 0 || klo + 160 > L) {
#pragma unroll
                    for (int kb = 0; kb < 5; ++kb)
#pragma unroll
                        for (int r = 0; r < 16; ++r) { const int ku = klo + kb * 32 + crow(r, hi); if (ku < 0 || ku >= L) s[kb][r] = -1e30f; }
                }
                float mx = -1e30f;
#pragma unroll
                for (int kb = 0; kb < 5; ++kb)
#pragma unroll
                    for (int r = 0; r < 16; ++r) mx = fmaxf(mx, s[kb][r]);
                mx = swap_max(mx);
                float ls = 0.f;
#pragma unroll
                for (int kb = 0; kb < 5; ++kb)
#pragma unroll
                    for (int r = 0; r < 16; ++r) { s[kb][r] = fexp2(s[kb][r] - mx); ls += s[kb][r]; }
                ls = swap_sum(ls);
                f32x16 o0 = {}, o1 = {};
#define D2_BATCH(J0) do { \
                s16x4 tv[5][4]; \
                tv[0][0] = tr_read<((J0) + 0) * 2048>(vb0); tv[0][1] = tr_read<((J0) + 0) * 2048 + 1024>(vb0); tv[0][2] = tr_read<((J0) + 0) * 2048>(vb1); tv[0][3] = tr_read<((J0) + 0) * 2048 + 1024>(vb1); \
                tv[1][0] = tr_read<((J0) + 1) * 2048>(vb0); tv[1][1] = tr_read<((J0) + 1) * 2048 + 1024>(vb0); tv[1][2] = tr_read<((J0) + 1) * 2048>(vb1); tv[1][3] = tr_read<((J0) + 1) * 2048 + 1024>(vb1); \
                tv[2][0] = tr_read<((J0) + 2) * 2048>(vb0); tv[2][1] = tr_read<((J0) + 2) * 2048 + 1024>(vb0); tv[2][2] = tr_read<((J0) + 2) * 2048>(vb1); tv[2][3] = tr_read<((J0) + 2) * 2048 + 1024>(vb1); \
                tv[3][0] = tr_read<((J0) + 3) * 2048>(vb0); tv[3][1] = tr_read<((J0) + 3) * 2048 + 1024>(vb0); tv[3][2] = tr_read<((J0) + 3) * 2048>(vb1); tv[3][3] = tr_read<((J0) + 3) * 2048 + 1024>(vb1); \
                tv[4][0] = tr_read<((J0) + 4) * 2048>(vb0); tv[4][1] = tr_read<((J0) + 4) * 2048 + 1024>(vb0); tv[4][2] = tr_read<((J0) + 4) * 2048>(vb1); tv[4][3] = tr_read<((J0) + 4) * 2048 + 1024>(vb1); \
                LDS_WAIT(); SBAR(); \
                _Pragma("unroll") for (int jj = 0; jj < 5; ++jj) { const int j = (J0) + jj; const int kb = j >> 1, a8 = 8 * (j & 1); \
                    u32x4 w; w.x = pk2(s[kb][a8 + 0], s[kb][a8 + 1]); w.y = pk2(s[kb][a8 + 2], s[kb][a8 + 3]); w.z = pk2(s[kb][a8 + 4], s[kb][a8 + 5]); w.w = pk2(s[kb][a8 + 6], s[kb][a8 + 7]); \
                    const bf16x8 pf = *(bf16x8*)&w; \
                    o0 = __builtin_amdgcn_mfma_f32_32x32x16_bf16(PK8(tv[jj][0], tv[jj][1]), pf, o0, 0, 0, 0); \
                    o1 = __builtin_amdgcn_mfma_f32_32x32x16_bf16(PK8(tv[jj][2], tv[jj][3]), pf, o1, 0, 0, 0); } } while (0)
                D2_BATCH(0); D2_BATCH(5);
#undef D2_BATCH
                const float linv = frcp(ls);
                const int tq = mb + res + ((u0 + 32 * wq + r32) << dsh);
                if (MODE == 0) {
                    bf16_t* orow = P1 + (size_t)tq * LDP1 + g * 512 + h * 64;
#pragma unroll
                    for (int db = 0; db < 2; ++db)
#pragma unroll
                        for (int rg = 0; rg < 4; ++rg) {
                            const f32x16& o = db == 0 ? o0 : o1;
                            u32x2 w; w.x = pk2(o[4 * rg] * linv, o[4 * rg + 1] * linv); w.y = pk2(o[4 * rg + 2] * linv, o[4 * rg + 3] * linv);
                            *(u32x2*)(orow + db * 32 + 8 * rg + 4 * hi) = w;
                        }
                    if (hi == 0) LSE[((size_t)g * M + tq) * 8 + h] = mx + __builtin_amdgcn_logf(ls);
                } else {
                    const bf16_t* prow = P1 + (size_t)tq * LDP1 + h * 64;
                    u32x2 g0v[8], g1v[8], zv[8];
#pragma unroll
                    for (int db = 0; db < 2; ++db)
#pragma unroll
                        for (int rg = 0; rg < 4; ++rg) { const int d0 = db * 32 + 8 * rg + 4 * hi;
                            g0v[db * 4 + rg] = *(const u32x2*)(prow + d0); g1v[db * 4 + rg] = *(const u32x2*)(prow + 512 + d0); zv[db * 4 + rg] = *(const u32x2*)(prow + 3072 + d0); }
                    const float l0 = LSE[((size_t)0 * M + tq) * 8 + h], l1 = LSE[((size_t)1 * M + tq) * 8 + h], l2 = mx + __builtin_amdgcn_logf(ls);
                    const float mm = fmaxf(l0, fmaxf(l1, l2));
                    float w0 = fexp2(l0 - mm), w1 = fexp2(l1 - mm), w2 = fexp2(l2 - mm);
                    const float winv = frcp(w0 + w1 + w2); w0 *= winv; w1 *= winv; w2 *= winv * linv;
                    bf16_t* yrow = YC + (size_t)tq * D + 512 + h * 64;
#pragma unroll
                    for (int db = 0; db < 2; ++db)
#pragma unroll
                        for (int rg = 0; rg < 4; ++rg) {
                            const f32x16& o = db == 0 ? o0 : o1; const u32x2 a = g0v[db * 4 + rg], c = g1v[db * 4 + rg], z = zv[db * 4 + rg];
                            const float y0 = (w0 * bflo(a.x) + w1 * bflo(c.x) + w2 * o[4 * rg + 0]) * silu(bflo(z.x)), y1 = (w0 * bfhi(a.x) + w1 * bfhi(c.x) + w2 * o[4 * rg + 1]) * silu(bfhi(z.x));
                            const float y2 = (w0 * bflo(a.y) + w1 * bflo(c.y) + w2 * o[4 * rg + 2]) * silu(bflo(z.y)), y3 = (w0 * bfhi(a.y) + w1 * bfhi(c.y) + w2 * o[4 * rg + 3]) * silu(bfhi(z.y));
                            u32x2 w; w.x = pk2(y0, y1); w.y = pk2(y2, y3);
                            *(u32x2*)(yrow + db * 32 + 8 * rg + 4 * hi) = w;
                        }
                }
            }
        }
        __syncthreads();
    }
}

struct MrgTok { u32x4 o0, o1, o2, dz; float l0, l1, l2; };
__device__ __forceinline__ void merge_phase(const Params& p, int vcu, int G) {
    const int tid = opaque_tid(), lane = tid & 63, wave = tid >> 6, h = lane >> 3;
    const int gw = vcu * 8 + wave, NGW = G * 8;
    const bf16_t* P1 = (const bf16_t*)(p.ws + WS_P);
    const float* LSE = (const float*)(p.ws + WS_LSE);
    bf16_t* YC = (bf16_t*)(p.ws + WS_H);
#define MRG_LOAD(T, m) do { const bf16_t* pr_ = P1 + (size_t)(m) * LDP1; \
        T.o0 = *(const u32x4*)(pr_ + 8 * lane); T.o1 = *(const u32x4*)(pr_ + 512 + 8 * lane); T.o2 = *(const u32x4*)(pr_ + 1024 + 8 * lane); T.dz = *(const u32x4*)(pr_ + 3072 + 8 * lane); \
        T.l0 = LSE[((size_t)0 * M + (m)) * 8 + h]; T.l1 = LSE[((size_t)1 * M + (m)) * 8 + h]; T.l2 = LSE[((size_t)2 * M + (m)) * 8 + h]; } while (0)
#define MRG_COMPUTE(T, m) do { \
        const float mx = fmaxf(T.l0, fmaxf(T.l1, T.l2)); \
        float w0 = fexp2(T.l0 - mx), w1 = fexp2(T.l1 - mx), w2 = fexp2(T.l2 - mx); \
        const float inv = frcp(w0 + w1 + w2); w0 *= inv; w1 *= inv; w2 *= inv; \
        u32x4 w; \
        _Pragma("unroll") for (int i = 0; i < 4; ++i) { \
            const float ylo = (w0 * bflo(T.o0[i]) + w1 * bflo(T.o1[i]) + w2 * bflo(T.o2[i])) * silu(bflo(T.dz[i])); \
            const float yhi = (w0 * bfhi(T.o0[i]) + w1 * bfhi(T.o1[i]) + w2 * bfhi(T.o2[i])) * silu(bfhi(T.dz[i])); \
            w[i] = pk2(ylo, yhi); } \
        *(u32x4*)(YC + (size_t)(m) * D + 512 + 8 * lane) = w; } while (0)
    MrgTok A, B;
    int m = gw;
    if (m < M) MRG_LOAD(A, m);
    for (; m < M; m += 2 * NGW) {
        const int m2 = m + NGW, m3 = m + 2 * NGW;
        if (m2 < M) MRG_LOAD(B, m2);
        MRG_COMPUTE(A, m);
        if (m2 < M) {
            if (m3 < M) MRG_LOAD(A, m3);
            MRG_COMPUTE(B, m2);
        }
    }
#undef MRG_LOAD
#undef MRG_COMPUTE
}

__global__ void __launch_bounds__(512, 2) mega(Params p) {
    extern __shared__ __attribute__((aligned(16))) unsigned char lds_raw[];
    LAS unsigned char* lds = (LAS unsigned char*)lds_raw;
    const unsigned long long mgs = ((const unsigned long long*)__builtin_amdgcn_implicitarg_ptr())[11];
    const int G = gridDim.x, bx = blockIdx.x;
    const int vcu = (G % 8 == 0) ? (bx % 8) * (G / 8) + bx / 8 : bx;
    unsigned* bar = (unsigned*)(p.ws + WS_CTL);
    volatile LAS unsigned* xst = (volatile LAS unsigned*)(lds + (LDS_BYTES - 64));
    if (threadIdx.x < 2) xst[threadIdx.x] = 0u;
    __syncthreads();
    const XcdBarrier xb = xcd_barrier_post(bar, xst);
    unsigned char* ws = p.ws;
    if (mgs == 0x9e3779b97f4a7c15ull && threadIdx.x == 0) bar[4000] = 1u;
    bf16_t* H = (bf16_t*)(ws + WS_H);
    bf16_t* P = (bf16_t*)(ws + WS_P);
    const float* MOD = (const float*)(ws + WS_MOD);

    for (int rep = 0; rep < REP_PREP; ++rep) p0_prep(p, lds, vcu, G);
    xcd_barrier(xb);
    sw1_phase(p, lds, vcu);
    for (int rep = 0; rep < REP_PRE0; ++rep) prenorm_phase(p, 0, vcu, G);
    xcd_barrier(xb);
    for (int rep = 0; rep < REP_GEMM; ++rep) { pg8::Gemm g{H, (const bf16_t*)(ws + WS_WINE), M, 3072, 1024, 1024, 1 << 30, 0}; pg8::StaticOrder S; S.init(M, 3072, G, bx);
      pg8::EpiInE E{P}; pg8::gemm_phase(lds, g, S, E); }
    xcd_barrier(xb);
    { pg8::Gemm g{P + 2048, (const bf16_t*)(ws + WS_WUQ), M, 768, 256, LDP0, 1 << 30, 0}; pg8::StaticOrder S; S.init(M, 768, G, bx);
      pg8::EpiBf16 E{(bf16_t*)((unsigned char*)p.out + OUT_Q), 768}; pg8::gemm_phase(lds, g, S, E); }
    { pg8::Gemm g{P + 2304, (const bf16_t*)(ws + WS_WUKV), M, 1024, 128, LDP0, 1 << 30, 0}; pg8::StaticOrder S; S.init(M, 1024, G, bx);
      pg8::EpiBf16 E{(bf16_t*)((unsigned char*)p.out + OUT_KV), 1024}; pg8::gemm_phase(lds, g, S, E); }
    xcd_barrier(xb);
    mla_prep_phase(p, vcu, G);
    xcd_barrier(xb);
    {
        float gq = 0.f, gk = 0.f;
        for (int i = 0; i < 96; ++i) { gq = fmaxf(gq, fabsf(p.q_gain[i])); gk = fmaxf(gk, fabsf(p.k_gain[i])); }
        const float sbound = 96.f * gq * gk * QSCALE_B;
        for (int rep = 0; rep < REP_ATTN; ++rep) { if (sbound < 64.f) attn_dense_phase7<true>(p, lds, vcu); else attn_dense_phase3<false>(p, lds, vcu); }
    }
    xcd_barrier(xb);
    { pg8::Gemm g{P + 512, (const bf16_t*)(ws + WS_WOE), M, 1024, 1024, LDP0, 8, (2464 - 1024) * 2}; pg8::StaticOrder S; S.init(M, 1024, G, bx);
      pg8::EpiResid0 E{p.xp, p.xs, p.out, MOD, MOD + (size_t)NB * 3072, p.norm_g + D, H, (float*)(ws + WS_ROWSS)}; pg8::gemm_phase(lds, g, S, E); }
    xcd_barrier(xb);
    { pg8::Gemm g{H, (const bf16_t*)(ws + WS_WINO), M, 3584, 1024, 1024, 1 << 30, 0}; pg8::StaticOrder S; S.init(M, 3584, G, bx);
      pg8::EpiInO E{P, p.dq_gain, p.dk_gain, (const float*)(ws + WS_ROWSS), (const float*)(ws + WS_SW)}; pg8::gemm_phase(lds, g, S, E); }
    xcd_barrier(xb);
    for (int rep = 0; rep < REP_GMLP; ++rep) gmlp_phase(p, lds, vcu);
    xcd_barrier(xb);
    dilated_phase2<0>(p, lds, vcu);
    xcd_barrier(xb);
    dilated_phase2<1>(p, lds, vcu);
    xcd_barrier(xb);
    { pg8::Gemm g{H, (const bf16_t*)(ws + WS_WOO), M, 1024, 1024, 1024, 1 << 30, 0}; pg8::StaticOrder S; S.init(M, 1024, G, bx);
      pg8::EpiResid E{p.out, p.out + (size_t)MP * D, p.out, MOD + (size_t)NB * 3072 + 2048}; pg8::gemm_phase(lds, g, S, E); }
}

extern "C" void kernel_launch(void* const* d_in, const int* in_sizes, int n_in, void* d_out, int out_size, void* d_ws, size_t ws_size, hipStream_t stream) {
    static int grid = 0;
    if (grid == 0) {
        if (n_in != 25 || ws_size < WS_END || out_size != M * D) { fprintf(stderr, "kernel_launch: unexpected shapes (n_in %d, ws %zu, out %d)\n", n_in, ws_size, out_size); grid = -1; return; }
        int dev = 0, cus = 0, per_cu = 0;
        (void)hipGetDevice(&dev);
        (void)hipDeviceGetAttribute(&cus, hipDeviceAttributeMultiprocessorCount, dev);
        (void)hipFuncSetAttribute((const void*)mega, hipFuncAttributeMaxDynamicSharedMemorySize, LDS_BYTES);
        (void)hipOccupancyMaxActiveBlocksPerMultiprocessor(&per_cu, (const void*)mega, 512, LDS_BYTES);
        (void)hipGetLastError();
        grid = cus;
        fprintf(stderr, "kernel_launch: grid %d (cus %d, occupancy query %d)\n", grid, cus, per_cu);
    }
    if (grid < 0) return;
    (void)hipMemsetAsync((char*)d_ws + WS_CTL, 0, 16384, stream);
    Params p{};
    const float** f = (const float**)&p;
    for (int i = 0; i < 25; ++i) f[i] = (const float*)d_in[i];
    p.out = (float*)d_out; p.ws = (unsigned char*)d_ws; p.pad = 0ull;
    void* args[] = {&p};
    hipError_t e = hipLaunchCooperativeKernel((const void*)mega, dim3(grid), dim3(512), args, LDS_BYTES, stream);
    if (e != hipSuccess) fprintf(stderr, "kernel_launch: cooperative launch failed: %s (grid %d)\n", hipGetErrorString(e), grid);
}
```
